# Optimizing an MI355X kernel written in HIP

```python
import math
import jax, jax.numpy as jnp
from jax import lax
import numpy as np

D_MODEL = 4096
BATCH = 4
SEQ = 2048
DEPTH = 1

ATTN_HEADS = 16
HEAD_DIM = 128
ATTN_WIDTH = ATTN_HEADS * HEAD_DIM
DILATED_PATTERNS = ((128, 1), (512, 4), (2048, 16))
ROPE_THETA = 10000.0
SSM_WIDTH = D_MODEL // 2
SSM_GROUP = 16
SSM_GROUPS = SSM_WIDTH // SSM_GROUP
SSM_STATE = 64
N_DIRECTIONS = 2
DT_MIN = 1e-3
DT_MAX = 1e-1
D_FF = 3 * D_MODEL
CONV_WIDTH = 3
PLE_DIM = 256
N_BRANCHES = 2
IN_WIDTH = 3 * ATTN_WIDTH + SSM_WIDTH + N_BRANCHES * D_MODEL
EPS = 1e-6
NEG_BIG = -1e30

kernel_name = "hybrid_dilated_attn_s5_convffn_block"


def rms_norm(x, gain):
    xf = x.astype(jnp.float32)
    y = xf * lax.rsqrt(jnp.mean(xf * xf, axis=-1, keepdims=True) + EPS)
    return (y * gain.astype(jnp.float32)).astype(x.dtype)


def rope_tables(seq):
    pos = jnp.arange(seq, dtype=jnp.float32)
    inv_freq = ROPE_THETA ** (-jnp.arange(0, HEAD_DIM, 2, dtype=jnp.float32) / HEAD_DIM)
    ang = pos[:, None] * inv_freq[None, :]
    ang = jnp.concatenate([ang, ang], axis=-1)
    return jnp.cos(ang)[None, :, None, :], jnp.sin(ang)[None, :, None, :]


def apply_rope(t, cos, sin):
    tf = t.astype(jnp.float32)
    t1, t2 = jnp.split(tf, 2, axis=-1)
    return tf * cos + jnp.concatenate([-t2, t1], axis=-1) * sin


def _dilated_window_partial(q, k, v, dilation, n_side):
    bsz, seq, heads, hd = q.shape
    sub_len = seq // dilation
    n_sub = bsz * dilation

    def to_sub(t):
        return t.reshape(bsz, sub_len, dilation, heads, hd).transpose(0, 2, 1, 3, 4).reshape(n_sub, sub_len, heads, hd)

    blk = n_side
    n_blk = -(-sub_len // blk)
    pad = n_blk * blk - sub_len
    qb = jnp.pad(to_sub(q), ((0, 0), (0, pad), (0, 0), (0, 0))).reshape(n_sub, n_blk, blk, heads, hd)

    def band(t):
        tp = jnp.pad(to_sub(t), ((0, 0), (blk, pad + blk), (0, 0), (0, 0))).reshape(n_sub, n_blk + 2, blk, heads, hd)
        return jnp.concatenate([tp[:, :-2], tp[:, 1:-1], tp[:, 2:]], axis=2)

    kw, vw = band(k), band(v)
    s = jnp.einsum('nbqhd,nbkhd->nbhqk', qb, kw, preferred_element_type=jnp.float32)
    q_idx = jnp.arange(n_blk)[:, None, None] * blk + jnp.arange(blk)[None, :, None]
    k_idx = (jnp.arange(n_blk)[:, None, None] - 1) * blk + jnp.arange(3 * blk)[None, None, :]
    valid = (jnp.abs(k_idx - q_idx) <= n_side) & (k_idx >= 0) & (k_idx < sub_len)
    s = jnp.where(valid[None, :, None], s, NEG_BIG)
    m = jnp.max(s, axis=-1)
    e = jnp.exp(s - m[..., None])
    l = jnp.sum(e, axis=-1)
    o = jnp.einsum('nbhqk,nbkhd->nbqhd', e, vw.astype(jnp.float32))

    def from_sub(t):
        t = t[:, :sub_len]
        rest = t.shape[2:]
        t = t.reshape((bsz, dilation, sub_len) + rest)
        t = t.transpose((0, 2, 1) + tuple(range(3, 3 + len(rest))))
        return t.reshape((bsz, seq) + rest)

    o = from_sub(o.reshape(n_sub, n_blk * blk, heads, hd))
    m = from_sub(m.transpose(0, 1, 3, 2).reshape(n_sub, n_blk * blk, heads))
    l = from_sub(l.transpose(0, 1, 3, 2).reshape(n_sub, n_blk * blk, heads))
    return m, l, o


def dilated_mixture_attention(q, k, v):
    parts = [_dilated_window_partial(q, k, v, d, w // (2 * d)) for (w, d) in DILATED_PATTERNS]
    m_max = jnp.max(jnp.stack([pm for (pm, _, _) in parts]), axis=0)
    num = jnp.zeros(q.shape, jnp.float32)
    den = jnp.zeros(q.shape[:-1], jnp.float32)
    for (pm, pl, po) in parts:
        w = jnp.exp(pm - m_max)
        num = num + w[..., None] * po
        den = den + w * pl
    return num / den[..., None]


def _complex_affine_combine(e1, e2):
    a1r, a1i, b1r, b1i = e1
    a2r, a2i, b2r, b2i = e2
    return (a2r * a1r - a2i * a1i,
            a2r * a1i + a2i * a1r,
            a2r * b1r - a2i * b1i + b2r,
            a2r * b1i + a2i * b1r + b2i)


def s5_bidirectional_glu(u, lam_re, lam_im, log_dt, b_re, b_im, c_re, c_im, d_skip, w_glu, b_glu):
    bsz, seq, width = u.shape
    uf = u.astype(jnp.float32)
    ug = uf.reshape(bsz, seq, SSM_GROUPS, SSM_GROUP)
    y = uf * d_skip.astype(jnp.float32)
    for direction in range(N_DIRECTIONS):
        lr = lam_re[direction].astype(jnp.float32)
        li = lam_im[direction].astype(jnp.float32)
        dt = jnp.exp(log_dt[direction].astype(jnp.float32))[:, None]
        mag = jnp.exp(lr * dt)
        ar = mag * jnp.cos(li * dt)
        ai = mag * jnp.sin(li * dt)
        den = lr * lr + li * li
        fr = ((ar - 1.0) * lr + ai * li) / den
        fi = (ai * lr - (ar - 1.0) * li) / den
        br = b_re[direction].astype(jnp.float32)
        bi = b_im[direction].astype(jnp.float32)
        bbr = fr[..., None] * br - fi[..., None] * bi
        bbi = fr[..., None] * bi + fi[..., None] * br
        src = ug if direction == 0 else jnp.flip(ug, axis=1)
        xr = jnp.einsum('bsgc,gpc->sbgp', src, bbr)
        xi = jnp.einsum('bsgc,gpc->sbgp', src, bbi)
        a_r = jnp.broadcast_to(ar[None, None], (seq, 1, SSM_GROUPS, SSM_STATE))
        a_i = jnp.broadcast_to(ai[None, None], (seq, 1, SSM_GROUPS, SSM_STATE))
        _, _, hr, hi = lax.associative_scan(_complex_affine_combine, (a_r, a_i, xr, xi), axis=0)
        out = (jnp.einsum('sbgp,gcp->bsgc', hr, c_re[direction].astype(jnp.float32))
               - jnp.einsum('sbgp,gcp->bsgc', hi, c_im[direction].astype(jnp.float32)))
        if direction == 1:
            out = jnp.flip(out, axis=1)
        y = y + out.reshape(bsz, seq, width)
    z = jax.nn.gelu(y.astype(u.dtype), approximate=True)
    return z * jax.nn.sigmoid(z @ w_glu + b_glu)


def centred_depthwise_conv(a, w, b):
    half = CONV_WIDTH // 2
    seq = a.shape[1]
    ap = jnp.pad(a, ((0, 0), (half, CONV_WIDTH - 1 - half), (0, 0)))
    out = b
    for j in range(CONV_WIDTH):
        out = out + ap[:, j:j + seq] * w[j]
    return out


def setup_inputs(seed: int = 0) -> dict:
    key = jax.random.key(seed)
    ks = jax.random.split(key, 32)
    f32 = jnp.float32

    def nrm(k, shape, scale):
        return jax.random.normal(k, shape, f32) * scale

    def gain(k):
        return 1.0 + nrm(k, (DEPTH, D_MODEL), 0.02)

    G, P, CG = SSM_GROUPS, SSM_STATE, SSM_GROUP
    lam_re = -0.5 + nrm(ks[10], (DEPTH, N_DIRECTIONS, G, P), 0.01)
    lam_im = math.pi * jnp.arange(P, dtype=f32) + nrm(ks[11], (DEPTH, N_DIRECTIONS, G, P), 0.01)
    log_dt = jax.random.uniform(ks[12], (DEPTH, N_DIRECTIONS, G), f32, math.log(DT_MIN), math.log(DT_MAX))
    return {
        "x": nrm(ks[0], (BATCH, SEQ, D_MODEL), 1.0),
        "p": nrm(ks[1], (DEPTH, BATCH, SEQ, PLE_DIM), 1.0),
        "g_mix_pre": gain(ks[2]),
        "g_mix_post": gain(ks[3]),
        "w_in": nrm(ks[4], (DEPTH, D_MODEL, IN_WIDTH), D_MODEL ** -0.5),
        "w_branch_attn": nrm(ks[5], (DEPTH, ATTN_WIDTH, D_MODEL), ATTN_WIDTH ** -0.5),
        "w_branch_ssm": nrm(ks[6], (DEPTH, SSM_WIDTH, D_MODEL), SSM_WIDTH ** -0.5),
        "w_out": nrm(ks[7], (DEPTH, D_MODEL, D_MODEL), D_MODEL ** -0.5),
        "ssm_lambda_re": lam_re,
        "ssm_lambda_im": lam_im,
        "ssm_log_dt": log_dt,
        "ssm_b_re": nrm(ks[13], (DEPTH, N_DIRECTIONS, G, P, CG), (2 * CG) ** -0.5),
        "ssm_b_im": nrm(ks[14], (DEPTH, N_DIRECTIONS, G, P, CG), (2 * CG) ** -0.5),
        "ssm_c_re": nrm(ks[15], (DEPTH, N_DIRECTIONS, G, CG, P), P ** -0.5),
        "ssm_c_im": nrm(ks[16], (DEPTH, N_DIRECTIONS, G, CG, P), P ** -0.5),
        "ssm_d": nrm(ks[17], (DEPTH, SSM_WIDTH), 1.0),
        "w_glu": nrm(ks[18], (DEPTH, SSM_WIDTH, SSM_WIDTH), SSM_WIDTH ** -0.5),
        "b_glu": nrm(ks[19], (DEPTH, SSM_WIDTH), 0.01),
        "g_ffn_pre": gain(ks[20]),
        "g_ffn_post": gain(ks[21]),
        "w_up": nrm(ks[22], (DEPTH, D_MODEL, 2 * D_FF), D_MODEL ** -0.5),
        "conv_w": nrm(ks[23], (DEPTH, CONV_WIDTH, D_FF), CONV_WIDTH ** -0.5),
        "conv_b": nrm(ks[24], (DEPTH, D_FF), 0.01),
        "w_down": nrm(ks[25], (DEPTH, D_FF, D_MODEL), D_FF ** -0.5),
        "w_ple": nrm(ks[26], (DEPTH, PLE_DIM, D_MODEL), PLE_DIM ** -0.5),
        "g_ple": gain(ks[27]),
        "w_ple_gate": nrm(ks[28], (DEPTH, D_MODEL, D_MODEL), D_MODEL ** -0.5),
    }


def reference(x, p, g_mix_pre, g_mix_post, w_in, w_branch_attn, w_branch_ssm, w_out,
              ssm_lambda_re, ssm_lambda_im, ssm_log_dt, ssm_b_re, ssm_b_im, ssm_c_re, ssm_c_im,
              ssm_d, w_glu, b_glu, g_ffn_pre, g_ffn_post, w_up, conv_w, conv_b, w_down,
              w_ple, g_ple, w_ple_gate):
    bsz, seq, _ = x.shape
    cos, sin = rope_tables(seq)
    splits = [ATTN_WIDTH, 2 * ATTN_WIDTH, 3 * ATTN_WIDTH, 3 * ATTN_WIDTH + SSM_WIDTH,
              3 * ATTN_WIDTH + SSM_WIDTH + D_MODEL]
    h = x
    for i in range(DEPTH):
        hn = rms_norm(h, g_mix_pre[i])
        proj = hn @ w_in[i]
        q, k, v, u, gate_a, gate_b = jnp.split(proj, splits, axis=-1)
        q = apply_rope(q.reshape(bsz, seq, ATTN_HEADS, HEAD_DIM), cos, sin) * (HEAD_DIM ** -0.5)
        k = apply_rope(k.reshape(bsz, seq, ATTN_HEADS, HEAD_DIM), cos, sin)
        v = v.reshape(bsz, seq, ATTN_HEADS, HEAD_DIM).astype(jnp.float32)
        y_a = dilated_mixture_attention(q, k, v).reshape(bsz, seq, ATTN_WIDTH).astype(h.dtype)
        y_b = s5_bidirectional_glu(u, ssm_lambda_re[i], ssm_lambda_im[i], ssm_log_dt[i],
                                   ssm_b_re[i], ssm_b_im[i], ssm_c_re[i], ssm_c_im[i],
                                   ssm_d[i], w_glu[i], b_glu[i])
        merged = (jax.nn.sigmoid(gate_a) * (y_a @ w_branch_attn[i])
                  + jax.nn.sigmoid(gate_b) * (y_b @ w_branch_ssm[i]))
        h = h + rms_norm(merged @ w_out[i], g_mix_post[i])
        hn = rms_norm(h, g_ffn_pre[i])
        a, b = jnp.split(hn @ w_up[i], [D_FF], axis=-1)
        a = centred_depthwise_conv(a, conv_w[i], conv_b[i])
        h = h + rms_norm((jax.nn.gelu(a, approximate=True) * b) @ w_down[i], g_ffn_post[i])
        ple = rms_norm(p[i] @ w_ple[i], g_ple[i])
        h = h + jax.nn.sigmoid(h @ w_ple_gate[i]) * ple
    return h
```

```cpp
#include <hip/hip_runtime.h>
#include <cstdio>
#include <cstdint>

__device__ __forceinline__ int lane_id() { int l; asm volatile("v_mbcnt_lo_u32_b32 %0, -1, 0\n\tv_mbcnt_hi_u32_b32 %0, -1, %0" : "=v"(l)); return l; }

namespace pg8 {
#define PG8_LAS __attribute__((address_space(3)))
typedef unsigned short bf16_t;
typedef short bf16x8 __attribute__((ext_vector_type(8)));
typedef float f32x4 __attribute__((ext_vector_type(4)));
typedef unsigned u32x4 __attribute__((ext_vector_type(4)));
constexpr int BM = 256, BK = 64, HALF = 128, HTB = HALF * BK * 2, STAGE_BYTES = 8 * HTB, NXCD = 8, WGM = 8;

__host__ __device__ __forceinline__ int lds_byte(int r, int c) { const int st = (r >> 4) * 2 + (c >> 5), rr = r & 15, cc = c & 31, ob = rr * 64 + cc * 2; return st * 1024 + (ob ^ (((ob >> 9) & 1) << 5)); }
__host__ __device__ __forceinline__ void stage_rc(int b, int& R, int& C) { const int st = b / 1024, sb = b % 1024, swz = sb ^ (((sb >> 9) & 1) << 5); R = (st >> 1) * 16 + swz / 64; C = (st & 1) * 32 + (swz % 64) / 2; }
__host__ __device__ __forceinline__ int perm32(int rho) { const int n = rho >> 4, i = rho & 15; return 8 * (i >> 2) + 4 * n + (i & 3); }

struct Unit { int pm, pn; };
struct Gemm { const bf16_t* A; const bf16_t* Bt; int M, N, K; };

struct StaticOrder {
    int nM, nN, nwg, G, c;
    __host__ __device__ void init(int M, int N, int G_, int c_) { nM = M / BM; nN = N / BM; nwg = nM * nN; G = G_; c = c_; }
    __host__ __device__ bool next(int i, Unit& u) const {
        const long L = (long)i * G + c; if (L >= nwg) return false;
        int wgid = (int)L; { const int q = nwg / NXCD, r = nwg % NXCD, xcd = wgid % NXCD, off = wgid / NXCD; wgid = (xcd < r ? xcd * (q + 1) : r * (q + 1) + (xcd - r) * q) + off; }
        const int nig = WGM * nN, gid = wgid / nig, fm = gid * WGM, gsz = (nM - fm) < WGM ? (nM - fm) : WGM;
        u.pm = fm + ((wgid % nig) % gsz); u.pn = (wgid % nig) / gsz; return true;
    }
    __device__ __forceinline__ void a_ready(const Unit&) const {}
    __device__ __forceinline__ void done(const Unit&) const {}
};

typedef float f32x2_t __attribute__((ext_vector_type(2))); typedef __bf16 bf16x2_t __attribute__((ext_vector_type(2)));
__device__ __forceinline__ unsigned cvt_pk_bf16(float lo, float hi) { f32x2_t v = {lo, hi}; bf16x2_t b = __builtin_convertvector(v, bf16x2_t); return __builtin_bit_cast(unsigned, b); }

template <class Epi, class Sched, bool ALIGN_EPI = false, bool SP2 = false>
__device__ __forceinline__ void gemm_phase(PG8_LAS unsigned char* lds, const Gemm g, const Sched& S, const Epi& E, int wid) {
    int lane = lane_id(); asm volatile("" : "+v"(lane));
    const int tid = wid * 64 + lane, wr = wid >> 2, wc = wid & 3, fr = lane & 15, fq = lane >> 4;
    const int K = g.K, nt = K / BK;
    unsigned voffA[2], voffB[2];
#pragma unroll
    for (int i = 0; i < 2; ++i) { int R, C; stage_rc(tid * 16 + i * 8192, R, C); const int Rb = Epi::PERM ? ((R & ~31) + perm32(R & 31)) : R;
        voffA[i] = (unsigned)(R * K + C) * 2u; voffB[i] = (unsigned)(Rb * K + C) * 2u; }
    const size_t kstep = (size_t)(BK * 2);
    const size_t hstep = (size_t)HALF * K * 2;
    const size_t tstep = 2 * hstep;
    const unsigned ldsw = (unsigned)wid * 1024u;
    const int aoff = lds_byte(wr * 64 + fr, fq * 8), boff = lds_byte(wc * 32 + fr, fq * 8);
#define PG8_SA(b, h) (((b) * 2 + (h)) * HTB)
#define PG8_SB(b, h) ((4 + (b) * 2 + (h)) * HTB)
#define PG8_STAGE(bufoff, gbase, voff) do { _Pragma("unroll") for (int _i = 0; _i < 2; ++_i) \
        __builtin_amdgcn_global_load_lds((const unsigned*)((const char*)(gbase) + (voff)[_i]), (PG8_LAS unsigned*)(lds + (bufoff) + ldsw + _i * 8192), 16, 0, 0); } while (0)
#define PG8_LDA(dst, b, h) do { _Pragma("unroll") for (int m = 0; m < 4; ++m) _Pragma("unroll") for (int k = 0; k < 2; ++k) dst[m][k] = *(const PG8_LAS bf16x8*)(lds + PG8_SA(b, h) + aoff + m * 2048 + k * 1024); } while (0)
#define PG8_LDB(dst, b, h) do { _Pragma("unroll") for (int n = 0; n < 2; ++n) _Pragma("unroll") for (int k = 0; k < 2; ++k) dst[n][k] = *(const PG8_LAS bf16x8*)(lds + PG8_SB(b, h) + boff + n * 2048 + k * 1024); } while (0)
#define PG8_MMA(ai, bj, At, Bt) do { __builtin_amdgcn_s_setprio(1); _Pragma("unroll") for (int m = 0; m < 4; ++m) _Pragma("unroll") for (int n = 0; n < 2; ++n) _Pragma("unroll") for (int k = 0; k < 2; ++k) \
        acc[ai][bj][m][n] = __builtin_amdgcn_mfma_f32_16x16x32_bf16(Bt[n][k], At[m][k], acc[ai][bj][m][n], 0, 0, 0); __builtin_amdgcn_s_setprio(0); } while (0)
#define PG8_WAIT_V(n) asm volatile("s_waitcnt vmcnt(" #n ")" ::: "memory")
#define PG8_WAIT_L(n) asm volatile("s_waitcnt lgkmcnt(" #n ")" ::: "memory")
#define PG8_BAR __builtin_amdgcn_s_barrier()
#define PG8_SCHED __builtin_amdgcn_sched_barrier(0)
    Unit cur, nxt; int ui = 0;
    if (!S.next(0, cur)) return;
    f32x4 acc[2][2][4][2];
#pragma unroll
    for (int a = 0; a < 2; ++a)
#pragma unroll
        for (int b = 0; b < 2; ++b)
#pragma unroll
            for (int m = 0; m < 4; ++m)
#pragma unroll
                for (int n = 0; n < 2; ++n) acc[a][b][m][n] = (f32x4){0.f, 0.f, 0.f, 0.f};
    bf16x8 At[4][2], B0[2][2], B1[2][2];
    const char* cA = (const char*)g.A + (size_t)cur.pm * tstep; const char* cB = (const char*)g.Bt + (size_t)cur.pn * tstep;
    S.a_ready(cur);
    if constexpr (SP2) {
        PG8_STAGE(PG8_SB(0, 0), cB, voffB); PG8_STAGE(PG8_SB(0, 1), cB + hstep, voffB); PG8_STAGE(PG8_SA(0, 0), cA, voffA); PG8_STAGE(PG8_SA(0, 1), cA + hstep, voffA);
        if (wr == 1) PG8_BAR;
        PG8_WAIT_V(2); PG8_BAR;
        PG8_STAGE(PG8_SB(1, 0), cB + kstep, voffB); PG8_STAGE(PG8_SA(1, 0), cA + kstep, voffA); PG8_STAGE(PG8_SB(1, 1), cB + hstep + kstep, voffB);
        PG8_WAIT_V(6); PG8_BAR;
    } else {
        PG8_STAGE(PG8_SB(0, 0), cB, voffB); PG8_STAGE(PG8_SA(0, 0), cA, voffA); PG8_STAGE(PG8_SB(0, 1), cB + hstep, voffB); PG8_STAGE(PG8_SA(0, 1), cA + hstep, voffA);
        if (wr == 1) PG8_BAR;
        PG8_WAIT_V(4); PG8_BAR;
        PG8_STAGE(PG8_SB(1, 0), cB + kstep, voffB); PG8_STAGE(PG8_SA(1, 0), cA + kstep, voffA); PG8_STAGE(PG8_SB(1, 1), cB + hstep + kstep, voffB);
        PG8_WAIT_V(6); PG8_BAR;
    }
    for (;;) {
        const bool has_next = S.next(ui + 1, nxt);
        const char* nA = has_next ? (const char*)g.A + (size_t)nxt.pm * tstep : cA; const char* nB = has_next ? (const char*)g.Bt + (size_t)nxt.pn * tstep : cB;
        for (int t = 0; t < nt; t += 2) {
            const bool last = (t == nt - 2);
            const char* a1 = cA + (size_t)(t + 1) * kstep;
            const char* a2 = last ? nA : cA + (size_t)(t + 2) * kstep; const char* b2 = last ? nB : cB + (size_t)(t + 2) * kstep;
            const char* a3 = a2 + kstep; const char* b3 = b2 + kstep;
            if (last && has_next) S.a_ready(nxt);
            if constexpr (SP2) {
            PG8_LDB(B0, 0, 0); PG8_LDB(B1, 0, 1); PG8_SCHED; PG8_LDA(At, 0, 0); PG8_STAGE(PG8_SA(1, 1), a1 + hstep, voffA);
            PG8_WAIT_V(8); PG8_WAIT_L(0); PG8_BAR; PG8_MMA(0, 0, At, B0); PG8_MMA(0, 1, At, B1); PG8_BAR; PG8_SCHED;
            PG8_LDA(At, 0, 1); PG8_STAGE(PG8_SB(0, 0), b2, voffB); PG8_STAGE(PG8_SB(0, 1), b2 + hstep, voffB); PG8_STAGE(PG8_SA(0, 0), a2, voffA);
            PG8_WAIT_V(8); PG8_WAIT_L(0); PG8_BAR; PG8_MMA(1, 0, At, B0); PG8_MMA(1, 1, At, B1); PG8_BAR; PG8_SCHED;
            PG8_LDB(B0, 1, 0); PG8_LDB(B1, 1, 1); PG8_SCHED; PG8_LDA(At, 1, 0); PG8_STAGE(PG8_SA(0, 1), a2 + hstep, voffA);
            PG8_WAIT_V(8); PG8_WAIT_L(0); PG8_BAR; PG8_MMA(0, 0, At, B0); PG8_MMA(0, 1, At, B1); PG8_BAR; PG8_SCHED;
            PG8_LDA(At, 1, 1); PG8_STAGE(PG8_SB(1, 0), b3, voffB); PG8_STAGE(PG8_SB(1, 1), b3 + hstep, voffB); PG8_STAGE(PG8_SA(1, 0), a3, voffA);
            PG8_WAIT_V(8); PG8_WAIT_L(0); PG8_BAR; PG8_MMA(1, 0, At, B0); PG8_MMA(1, 1, At, B1); PG8_BAR; PG8_SCHED;
            } else {
            PG8_LDB(B0, 0, 0); PG8_SCHED; PG8_LDA(At, 0, 0); PG8_STAGE(PG8_SA(1, 1), a1 + hstep, voffA);
            PG8_WAIT_L(8); PG8_BAR; PG8_WAIT_L(0); PG8_MMA(0, 0, At, B0); PG8_BAR; PG8_SCHED;
            PG8_LDB(B1, 0, 1); PG8_STAGE(PG8_SB(0, 0), b2, voffB);
            PG8_BAR; PG8_WAIT_L(0); PG8_MMA(0, 1, At, B1); PG8_BAR;
            PG8_LDA(At, 0, 1); PG8_STAGE(PG8_SA(0, 0), a2, voffA);
            PG8_BAR; PG8_WAIT_L(0); PG8_MMA(1, 0, At, B0); PG8_BAR; PG8_SCHED;
            PG8_STAGE(PG8_SB(0, 1), b2 + hstep, voffB);
            PG8_WAIT_V(6); PG8_BAR; PG8_MMA(1, 1, At, B1); PG8_BAR;
            PG8_LDB(B0, 1, 0); PG8_SCHED; PG8_LDA(At, 1, 0); PG8_STAGE(PG8_SA(0, 1), a2 + hstep, voffA);
            PG8_WAIT_L(8); PG8_BAR; PG8_WAIT_L(0); PG8_MMA(0, 0, At, B0); PG8_BAR; PG8_SCHED;
            PG8_LDB(B1, 1, 1); PG8_STAGE(PG8_SB(1, 0), b3, voffB);
            PG8_BAR; PG8_WAIT_L(0); PG8_MMA(0, 1, At, B1); PG8_BAR;
            PG8_LDA(At, 1, 1); PG8_STAGE(PG8_SA(1, 0), a3, voffA);
            PG8_BAR; PG8_WAIT_L(0); PG8_MMA(1, 0, At, B0); PG8_BAR; PG8_SCHED;
            PG8_STAGE(PG8_SB(1, 1), b3 + hstep, voffB);
            PG8_WAIT_V(6); PG8_BAR; PG8_MMA(1, 1, At, B1); PG8_BAR;
            }
        }
        if constexpr (ALIGN_EPI) { if (wr == 0) PG8_BAR; }
        E(acc, cur, wr, wc, fr, fq);
        if (!has_next) break;
#pragma unroll
        for (int a = 0; a < 2; ++a)
#pragma unroll
            for (int b = 0; b < 2; ++b)
#pragma unroll
                for (int m = 0; m < 4; ++m)
#pragma unroll
                    for (int n = 0; n < 2; ++n) acc[a][b][m][n] = (f32x4){0.f, 0.f, 0.f, 0.f};
        cur = nxt; cA = nA; cB = nB; ++ui;
        if constexpr (ALIGN_EPI) { if (wr == 1) PG8_BAR; }
    }
    PG8_WAIT_V(0);
    if constexpr (!ALIGN_EPI) { if (wr == 0) PG8_BAR; }
    PG8_BAR;
#undef PG8_SA
#undef PG8_SB
#undef PG8_STAGE
#undef PG8_LDA
#undef PG8_LDB
#undef PG8_MMA
#undef PG8_WAIT_V
#undef PG8_WAIT_L
#undef PG8_BAR
#undef PG8_SCHED
}
}

constexpr int DM = 4096, NB = 4, SEQ = 2048, MTOK = NB * SEQ;
constexpr int AH = 16, HD = 128, AW = 2048;
constexpr int SW = 2048, SG = 16, NG = 128, SP = 64;
constexpr int DFF = 12288, PLED = 256, INW = 16384;
constexpr float EPS = 1e-6f;
constexpr int NWAVES = 8;

constexpr size_t MiB = 1u << 20;
constexpr size_t WS_CTL = 0, CTL_ZERO_BYTES = 1 * MiB;
constexpr size_t WS_ROPE = 1 * MiB;
constexpr size_t WS_RPLE = 2 * MiB;
constexpr size_t WS_ML = 3 * MiB;
constexpr size_t WS_SSMC = 6 * MiB;
constexpr size_t WS_PB = 8 * MiB;
constexpr size_t WS_WIN = 16 * MiB, WS_WA = 144 * MiB, WS_WB = 160 * MiB, WS_WOUT = 176 * MiB, WS_WGLU = 208 * MiB, WS_WUP = 216 * MiB,
                 WS_WDOWN = 408 * MiB, WS_WPLE = 504 * MiB, WS_WPG = 506 * MiB;
constexpr size_t WS_XN = 540 * MiB;
constexpr size_t WS_PLEB = 604 * MiB;
constexpr size_t WS_OUT1 = 668 * MiB;
constexpr size_t WS_Q = 732 * MiB, WS_K = 764 * MiB, WS_V = 796 * MiB, WS_U = 828 * MiB, WS_GA = 860 * MiB, WS_GB = 924 * MiB;
constexpr size_t WS_PART = 988 * MiB;
constexpr size_t WS_Y0 = 1084 * MiB, WS_Y1 = 1148 * MiB;
constexpr size_t WS_YA = 1212 * MiB, WS_Z = 1244 * MiB, WS_YB = 1276 * MiB;
constexpr size_t WS_TMP = 1308 * MiB;
constexpr size_t WS_EA = 732 * MiB, WS_EB = 764 * MiB, WS_ACT = 1116 * MiB;
constexpr size_t WS_END = 1372 * MiB;
constexpr int CW_BAR = 4096, CW_QUEUE = 8192;

constexpr int RING_OFF = 0, RING_BYTES = 131072;
constexpr int SSM_WAVE_BYTES = 32 * 129 * 4;
constexpr int MISC_OFF = 135168;
constexpr int LDS_BYTES = 147456;
static_assert(8 * SSM_WAVE_BYTES <= MISC_OFF && MISC_OFF + 128 <= LDS_BYTES, "LDS map");

#define GAS __attribute__((address_space(1)))
#define LAS __attribute__((address_space(3)))
typedef unsigned short bf16;
typedef unsigned v4u __attribute__((ext_vector_type(4)));
typedef unsigned v2u __attribute__((ext_vector_type(2)));
typedef float f32x4 __attribute__((ext_vector_type(4)));
typedef float f32x16 __attribute__((ext_vector_type(16)));
typedef short bf16x8 __attribute__((ext_vector_type(8)));
typedef short s16x4 __attribute__((ext_vector_type(4)));
#define LDS_WAIT() asm volatile("s_waitcnt lgkmcnt(0)" ::: "memory")
#define VM_WAIT() asm volatile("s_waitcnt vmcnt(0)" ::: "memory")
__device__ __forceinline__ unsigned pk2(float lo, float hi) { return pg8::cvt_pk_bf16(lo, hi); }
__device__ __forceinline__ float bflo(unsigned w) { return __uint_as_float(w << 16); }
__device__ __forceinline__ float bfhi(unsigned w) { return __uint_as_float(w & 0xffff0000u); }
__device__ __forceinline__ float sigm(float x) { return __builtin_amdgcn_rcpf(1.f + __builtin_amdgcn_exp2f(-1.4426950408889634f * x)); }
__device__ __forceinline__ float gelu_tanh(float x) { return x * sigm(1.5957691216057308f * x * (1.f + 0.044715f * x * x)); }
template <int X> __device__ __forceinline__ float swz_xor(float v) { return __int_as_float(__builtin_amdgcn_ds_swizzle(__float_as_int(v), (X << 10) | 0x1f)); }
__device__ __forceinline__ float wave_sum(float v) {
    v += swz_xor<1>(v); v += swz_xor<2>(v); v += swz_xor<4>(v); v += swz_xor<8>(v); v += swz_xor<16>(v);
    auto rr = __builtin_amdgcn_permlane32_swap(__float_as_uint(v), __float_as_uint(v), false, false);
    return __uint_as_float(rr[0]) + __uint_as_float(rr[1]);
}

#define XB_TMO      128
#define XB_XCNT(j)  (256  + 64 * (j))
#define XB_XSUB(j)  (1280 + 64 * (j))
#define XB_XGEN(j)  (2304 + 64 * (j))
#define XB_TOP      3328
#define XB_TOPGEN   3392
#define XCD_BAR_WORDS 3456
#define XB_SPIN_CAP (1u << 18)
__device__ __forceinline__ unsigned xb_ld(unsigned* p)              { return __hip_atomic_load(p, __ATOMIC_RELAXED, __HIP_MEMORY_SCOPE_AGENT); }
__device__ __forceinline__ unsigned xb_add(unsigned* p, unsigned v) { return __hip_atomic_fetch_add(p, v, __ATOMIC_RELAXED, __HIP_MEMORY_SCOPE_AGENT); }
__device__ __forceinline__ unsigned xb_xcc_id() { return (unsigned)__builtin_amdgcn_s_getreg((3 << 11) | 20) & 0xFu; }
#define XB_SPIN(cond, bar) do { unsigned _sp = 0; while (cond) { __builtin_amdgcn_s_sleep(1); \
    if ((++_sp & 255u) == 0u) { if (xb_ld(&(bar)[XB_TMO])) break; if (_sp > XB_SPIN_CAP) { atomicAdd(&(bar)[XB_TMO], 1u); break; } } } } while (0)
struct XcdBarrier { unsigned* bar; unsigned x; volatile LAS unsigned* st; int wave; };
__device__ __forceinline__ XcdBarrier xcd_barrier_post(unsigned* bar, volatile LAS unsigned* st, int wave) {
    XcdBarrier b; b.bar = bar; b.x = xb_xcc_id(); b.st = st; b.wave = wave;
    if (wave == 0 && lane_id() == 0) (void)xb_add(&bar[XB_XCNT(b.x)], 1u);
    return b;
}
__device__ __forceinline__ void xcd_barrier_complete(unsigned* bar, unsigned x, unsigned& nloc, unsigned& nx) {
    const unsigned G = gridDim.x * gridDim.y * gridDim.z;
    unsigned sum, cnt, mine, sp = 0u;
    for (;;) {
        sum = 0u; cnt = 0u; mine = 0u;
#pragma unroll
        for (unsigned j = 0; j < 16; ++j) { const unsigned c = xb_ld(&bar[XB_XCNT(j)]); sum += c; cnt += (c > 0u) ? 1u : 0u; mine = (j == x) ? c : mine; }
        if (sum == G) break;
        __builtin_amdgcn_s_sleep(1);
        if ((++sp & 255u) == 0u) { if (xb_ld(&bar[XB_TMO])) break; if (sp > XB_SPIN_CAP) { atomicAdd(&bar[XB_TMO], 1u); break; } }
    }
    nloc = mine > 0u ? mine : 1u; nx = cnt > 0u ? cnt : 1u;
}
__device__ __forceinline__ void xcd_barrier(const XcdBarrier& b) {
    asm volatile("s_waitcnt vmcnt(0)" ::: "memory");
    __syncthreads();
    if (b.wave == 0 && lane_id() == 0) {
        unsigned* bar = b.bar;
        __builtin_amdgcn_s_waitcnt(0);
        unsigned nloc = b.st[0], nx = b.st[1];
        if (nloc == 0u) { xcd_barrier_complete(bar, b.x, nloc, nx); b.st[0] = nloc; b.st[1] = nx; }
        const unsigned old = xb_add(&bar[XB_XSUB(b.x)], 1u);
        const unsigned gen = old / nloc;
        if (old + 1u == (gen + 1u) * nloc) {
            __builtin_amdgcn_fence(__ATOMIC_RELEASE, "agent");
            asm volatile("s_waitcnt vmcnt(0)" ::: "memory");
            const unsigned og = xb_add(&bar[XB_TOP], 1u);
            const unsigned tg = og / nx;
            if (og + 1u == (tg + 1u) * nx) xb_add(&bar[XB_TOPGEN], 1u);
            else XB_SPIN(xb_ld(&bar[XB_TOPGEN]) == tg, bar);
            __builtin_amdgcn_fence(__ATOMIC_ACQUIRE, "agent");
            xb_add(&bar[XB_XGEN(b.x)], 1u);
            asm volatile("s_waitcnt vmcnt(0)" ::: "memory");
        } else {
            XB_SPIN(xb_ld(&bar[XB_XGEN(b.x)]) == gen, bar);
            __builtin_amdgcn_fence(__ATOMIC_ACQUIRE, "agent");
            asm volatile("s_waitcnt vmcnt(0)" ::: "memory");
        }
    }
    __syncthreads();
}

using pg8::Unit;
struct EpiIn {
    static constexpr bool PERM = true;
    bf16 *Q, *K, *V, *U, *GA, *GB; const float* rope;
    __device__ __forceinline__ void operator()(const f32x4 (&acc)[2][2][4][2], const Unit& u, int wr, int wc, int fr, int fq) const {
        const int row0 = u.pm * 256 + wr * 64 + fr, cl = wc * 32 + 8 * fq;
        if (u.pn < 16) {
            bf16* base = (u.pn < 8 ? Q : K) + (u.pn & 7) * 256 + cl;
#pragma unroll
            for (int ai = 0; ai < 2; ++ai)
#pragma unroll
                for (int m = 0; m < 4; ++m) { const int row = row0 + ai * 128 + m * 16; const float* rp = rope + (size_t)(row & (SEQ - 1)) * 128 + (cl >> 1);
                    const f32x4 cs = *(const f32x4*)rp, sn = *(const f32x4*)(rp + 64);
#pragma unroll
                    for (int bj = 0; bj < 2; ++bj) { const f32x4 x1 = acc[ai][bj][m][0], x2 = acc[ai][bj][m][1];
                        const f32x4 o1 = x1 * cs - x2 * sn, o2 = x2 * cs + x1 * sn;
                        v4u w; w.x = pk2(o1[0], o1[1]); w.y = pk2(o1[2], o1[3]); w.z = pk2(o2[0], o2[1]); w.w = pk2(o2[2], o2[3]);
                        *(v4u*)(base + (size_t)row * AW + bj * 128) = w; } }
        } else if (u.pn < 24) {
            bf16* base = V + (u.pn & 7) * 256 + cl;
#pragma unroll
            for (int ai = 0; ai < 2; ++ai)
#pragma unroll
                for (int m = 0; m < 4; ++m) { const int row = row0 + ai * 128 + m * 16;
#pragma unroll
                    for (int bj = 0; bj < 2; ++bj) { const f32x4 v0 = acc[ai][bj][m][0], v1 = acc[ai][bj][m][1];
                        v4u w; w.x = pk2(v0[0], v0[1]); w.y = pk2(v0[2], v0[3]); w.z = pk2(v1[0], v1[1]); w.w = pk2(v1[2], v1[3]);
                        *(v4u*)(base + (size_t)row * AW + bj * 128) = w; } }
        } else if (u.pn < 32) {
#pragma unroll
            for (int bj = 0; bj < 2; ++bj) { const int col = (u.pn & 7) * 256 + bj * 128 + cl; bf16* base = U + ((size_t)(col >> 4) * MTOK) * SG + (col & 8);
#pragma unroll
                for (int ai = 0; ai < 2; ++ai)
#pragma unroll
                    for (int m = 0; m < 4; ++m) { const int row = row0 + ai * 128 + m * 16; const f32x4 v0 = acc[ai][bj][m][0], v1 = acc[ai][bj][m][1];
                        v4u w; w.x = pk2(v0[0], v0[1]); w.y = pk2(v0[2], v0[3]); w.z = pk2(v1[0], v1[1]); w.w = pk2(v1[2], v1[3]);
                        *(v4u*)(base + (size_t)row * SG) = w; } }
        } else {
            bf16* base = (u.pn < 48 ? GA : GB) + (u.pn & 15) * 256 + cl;
#pragma unroll
            for (int ai = 0; ai < 2; ++ai)
#pragma unroll
                for (int m = 0; m < 4; ++m) { const int row = row0 + ai * 128 + m * 16;
#pragma unroll
                    for (int bj = 0; bj < 2; ++bj) { const f32x4 v0 = acc[ai][bj][m][0], v1 = acc[ai][bj][m][1];
                        v4u w; w.x = pk2(sigm(v0[0]), sigm(v0[1])); w.y = pk2(sigm(v0[2]), sigm(v0[3])); w.z = pk2(sigm(v1[0]), sigm(v1[1])); w.w = pk2(sigm(v1[2]), sigm(v1[3]));
                        *(v4u*)(base + (size_t)row * DM + bj * 128) = w; } }
        }
    }
};
struct EpiPlain {
    static constexpr bool PERM = true;
    bf16* O; int ldc; int split_cols; size_t split_stride;
    __device__ __forceinline__ void operator()(const f32x4 (&acc)[2][2][4][2], const Unit& u, int wr, int wc, int fr, int fq) const {
        const int row0 = u.pm * 256 + wr * 64 + fr; int colt = u.pn * 256; bf16* base = O;
        if (split_cols) { const int t = colt / split_cols; base += (size_t)t * split_stride; colt -= t * split_cols; }
        base += colt + wc * 32 + 8 * fq;
#pragma unroll
        for (int ai = 0; ai < 2; ++ai)
#pragma unroll
            for (int m = 0; m < 4; ++m) { const int row = row0 + ai * 128 + m * 16;
#pragma unroll
                for (int bj = 0; bj < 2; ++bj) { const f32x4 v0 = acc[ai][bj][m][0], v1 = acc[ai][bj][m][1];
                    v4u w; w.x = pk2(v0[0], v0[1]); w.y = pk2(v0[2], v0[3]); w.z = pk2(v1[0], v1[1]); w.w = pk2(v1[2], v1[3]);
                    *(v4u*)(base + (size_t)row * ldc + bj * 128) = w; } }
    }
};
struct EpiGlu {
    static constexpr bool PERM = true;
    const bf16* Z; bf16* YB; const float* bias;
    __device__ __forceinline__ void operator()(const f32x4 (&acc)[2][2][4][2], const Unit& u, int wr, int wc, int fr, int fq) const {
        const int row0 = u.pm * 256 + wr * 64 + fr, col0 = u.pn * 256 + wc * 32 + 8 * fq;
#pragma unroll
        for (int bj = 0; bj < 2; ++bj) { const f32x4 b0 = *(const f32x4*)(bias + col0 + bj * 128), b1 = *(const f32x4*)(bias + col0 + bj * 128 + 4);
#pragma unroll
            for (int ai = 0; ai < 2; ++ai)
#pragma unroll
                for (int m = 0; m < 4; ++m) { const size_t off = (size_t)(row0 + ai * 128 + m * 16) * SW + col0 + bj * 128;
                    const v4u z = *(const v4u*)(Z + off); const f32x4 v0 = acc[ai][bj][m][0] + b0, v1 = acc[ai][bj][m][1] + b1;
                    v4u w; w.x = pk2(bflo(z.x) * sigm(v0[0]), bfhi(z.x) * sigm(v0[1])); w.y = pk2(bflo(z.y) * sigm(v0[2]), bfhi(z.y) * sigm(v0[3]));
                    w.z = pk2(bflo(z.z) * sigm(v1[0]), bfhi(z.z) * sigm(v1[1])); w.w = pk2(bflo(z.w) * sigm(v1[2]), bfhi(z.w) * sigm(v1[3]));
                    *(v4u*)(YB + off) = w; } }
    }
};
template <bool FIRST> struct EpiGate {
    static constexpr bool PERM = true;
    const bf16* G; bf16* T;
    __device__ __forceinline__ void operator()(const f32x4 (&acc)[2][2][4][2], const Unit& u, int wr, int wc, int fr, int fq) const {
        const int row0 = u.pm * 256 + wr * 64 + fr, col0 = u.pn * 256 + wc * 32 + 8 * fq;
#pragma unroll
        for (int ai = 0; ai < 2; ++ai)
#pragma unroll
            for (int m = 0; m < 4; ++m)
#pragma unroll
                for (int bj = 0; bj < 2; ++bj) { const size_t off = (size_t)(row0 + ai * 128 + m * 16) * DM + col0 + bj * 128;
                    const v4u g = *(const v4u*)(G + off); const f32x4 v0 = acc[ai][bj][m][0], v1 = acc[ai][bj][m][1];
                    float o[8] = { bflo(g.x) * v0[0], bfhi(g.x) * v0[1], bflo(g.y) * v0[2], bfhi(g.y) * v0[3], bflo(g.z) * v1[0], bfhi(g.z) * v1[1], bflo(g.w) * v1[2], bfhi(g.w) * v1[3] };
                    if (!FIRST) { const v4u t = *(const v4u*)(T + off);
                        o[0] += bflo(t.x); o[1] += bfhi(t.x); o[2] += bflo(t.y); o[3] += bfhi(t.y); o[4] += bflo(t.z); o[5] += bfhi(t.z); o[6] += bflo(t.w); o[7] += bfhi(t.w); }
                    v4u w; w.x = pk2(o[0], o[1]); w.y = pk2(o[2], o[3]); w.z = pk2(o[4], o[5]); w.w = pk2(o[6], o[7]);
                    *(v4u*)(T + off) = w; }
    }
};
template <int CTRL> __device__ __forceinline__ float dppf(float v) { return __int_as_float(__builtin_amdgcn_update_dpp(0, __float_as_int(v), CTRL, 0xf, 0xf, true)); }
struct EpiUp {
    static constexpr bool PERM = true;
    bf16* ACT; float* EA; float* EB; const float* cw; const float* cb;
    __device__ __forceinline__ void operator()(const f32x4 (&acc)[2][2][4][2], const Unit& u, int wr, int wc, int fr, int fq) const {
        const int ch0 = u.pn * 128 + wc * 32 + 8 * fq;
        f32x4 w0[2], w1[2], w2[2], bs[2];
#pragma unroll
        for (int n = 0; n < 2; ++n) { w0[n] = *(const f32x4*)(cw + ch0 + 4 * n); w1[n] = *(const f32x4*)(cw + DFF + ch0 + 4 * n); w2[n] = *(const f32x4*)(cw + 2 * DFF + ch0 + 4 * n); bs[n] = *(const f32x4*)(cb + ch0 + 4 * n); }
        const f32x4 zero4 = (f32x4){0.f, 0.f, 0.f, 0.f};
#pragma unroll
        for (int ai = 0; ai < 2; ++ai) {
            const int blk = u.pm * 4 + 2 * ai + wr; const int rowb = blk * 64;
#pragma unroll
            for (int m = 0; m < 4; ++m) {
                unsigned ow[4];
#pragma unroll
                for (int n = 0; n < 2; ++n) {
                    const f32x4 cur = acc[ai][0][m][n], up = m > 0 ? acc[ai][0][m - 1][n] : zero4, dn = m < 3 ? acc[ai][0][m + 1][n] : zero4, bv = acc[ai][1][m][n];
                    float o[4];
#pragma unroll
                    for (int e = 0; e < 4; ++e) {
                        const float p_in = dppf<0x111>(cur[e]), p_ed = dppf<0x121>(up[e]);
                        const float n_in = dppf<0x101>(cur[e]), n_ed = dppf<0x12F>(dn[e]);
                        const float prev = fr == 0 ? p_ed : p_in, next = fr == 15 ? n_ed : n_in;
                        o[e] = gelu_tanh(bs[n][e] + w0[n][e] * prev + w1[n][e] * cur[e] + w2[n][e] * next) * bv[e]; }
                    ow[2 * n] = pk2(o[0], o[1]); ow[2 * n + 1] = pk2(o[2], o[3]);
                }
                const bool first = (m == 0 && fr == 0), last = (m == 3 && fr == 15);
                if (!(first || last)) *(v4u*)(ACT + (size_t)(rowb + 16 * m + fr) * DFF + ch0) = (v4u){ow[0], ow[1], ow[2], ow[3]};
                if (m == 0 && fr < 2) { float* ea = EA + ((size_t)blk * 4 + fr) * DFF + ch0; *(f32x4*)ea = acc[ai][0][0][0]; *(f32x4*)(ea + 4) = acc[ai][0][0][1];
                    if (fr == 0) { float* eb = EB + ((size_t)blk * 2) * DFF + ch0; *(f32x4*)eb = acc[ai][1][0][0]; *(f32x4*)(eb + 4) = acc[ai][1][0][1]; } }
                if (m == 3 && fr >= 14) { float* ea = EA + ((size_t)blk * 4 + (fr - 12)) * DFF + ch0; *(f32x4*)ea = acc[ai][0][3][0]; *(f32x4*)(ea + 4) = acc[ai][0][3][1];
                    if (fr == 15) { float* eb = EB + ((size_t)blk * 2 + 1) * DFF + ch0; *(f32x4*)eb = acc[ai][1][3][0]; *(f32x4*)(eb + 4) = acc[ai][1][3][1]; } }
            }
        }
    }
};
struct EpiFinal {
    static constexpr bool PERM = true;
    float* out; const bf16* PLEB; const float* rple; const float* gple;
    __device__ __forceinline__ void operator()(const f32x4 (&acc)[2][2][4][2], const Unit& u, int wr, int wc, int fr, int fq) const {
        const int row0 = u.pm * 256 + wr * 64 + fr, col0 = u.pn * 256 + wc * 32 + 8 * fq;
#pragma unroll
        for (int bj = 0; bj < 2; ++bj) { const f32x4 g0 = *(const f32x4*)(gple + col0 + bj * 128), g1 = *(const f32x4*)(gple + col0 + bj * 128 + 4);
#pragma unroll
            for (int ai = 0; ai < 2; ++ai)
#pragma unroll
                for (int m = 0; m < 4; ++m) { const int row = row0 + ai * 128 + m * 16; const size_t off = (size_t)row * DM + col0 + bj * 128;
                    const float rs = rple[row]; const v4u pw = *(const v4u*)(PLEB + off);
                    const f32x4 h0 = *(const f32x4*)(out + off), h1 = *(const f32x4*)(out + off + 4); const f32x4 v0 = acc[ai][bj][m][0], v1 = acc[ai][bj][m][1];
                    f32x4 o0, o1;
                    o0[0] = h0[0] + sigm(v0[0]) * (bflo(pw.x) * rs * g0[0]); o0[1] = h0[1] + sigm(v0[1]) * (bfhi(pw.x) * rs * g0[1]);
                    o0[2] = h0[2] + sigm(v0[2]) * (bflo(pw.y) * rs * g0[2]); o0[3] = h0[3] + sigm(v0[3]) * (bfhi(pw.y) * rs * g0[3]);
                    o1[0] = h1[0] + sigm(v1[0]) * (bflo(pw.z) * rs * g1[0]); o1[1] = h1[1] + sigm(v1[1]) * (bfhi(pw.z) * rs * g1[1]);
                    o1[2] = h1[2] + sigm(v1[2]) * (bflo(pw.w) * rs * g1[2]); o1[3] = h1[3] + sigm(v1[3]) * (bfhi(pw.w) * rs * g1[3]);
                    *(f32x4*)(out + off) = o0; *(f32x4*)(out + off + 4) = o1; } }
    }
};

__device__ __forceinline__ int qk_perm(int n) {
    const int i = n & 127, b = n & ~127;
    return i < 64 ? b + 8 * (i >> 2) + (i & 3) : b + 8 * ((i - 64) >> 2) + 4 + (i & 3);
}
struct TRef { const float* W; bf16* WT; int K, N, item, up; };
__device__ __forceinline__ void titem_load(const TRef& t, float (&v)[32], int lane) {
    const int nblk = t.N >> 5, kb = t.item / nblk, nb = t.item - kb * nblk, k0 = kb << 6, n0 = nb << 5;
    const float* src = t.W + (size_t)(k0 + (lane >> 5)) * t.N + n0 + (lane & 31);
#pragma unroll
    for (int i = 0; i < 32; ++i) v[i] = src[(size_t)(2 * i) * t.N];
}
template <int MODE>
__device__ __forceinline__ void titem_store(const TRef& t, const float (&v)[32], LAS float* scr, int lane) {
    const int nblk = t.N >> 5, kb = t.item / nblk, nb = t.item - kb * nblk, k0 = kb << 6, n0 = nb << 5;
    unsigned d[16];
#pragma unroll
    for (int i = 0; i < 16; ++i) { auto r = __builtin_amdgcn_permlane32_swap(__float_as_uint(v[i]), __float_as_uint(v[i + 16]), false, false);
        d[i] = pk2(__uint_as_float(r[0]), __uint_as_float(r[1])); }
    LAS char* sb = (LAS char*)scr;
    LAS v4u* wp = (LAS v4u*)(sb + (lane & 31) * 144 + (lane >> 5) * 64);
#pragma unroll
    for (int q = 0; q < 4; ++q) wp[q] = (v4u){d[4 * q], d[4 * q + 1], d[4 * q + 2], d[4 * q + 3]};
    LDS_WAIT(); asm volatile("" ::: "memory");
    const int c = lane & 7;
#pragma unroll
    for (int j = 0; j < 4; ++j) { const int n = (lane >> 3) + 8 * j; const v4u o = *(const LAS v4u*)(sb + n * 144 + c * 16);
        int dn = n0 + n; if (MODE == 1) dn = (dn < 4096) ? qk_perm(dn) : dn;
        if (MODE == 2) { const int cch = dn < DFF ? dn : dn - DFF; dn = ((cch >> 7) << 8) + (dn < DFF ? 0 : 128) + (cch & 127); }
        *(v4u*)(t.WT + (size_t)dn * t.K + k0 + 8 * c) = o; }
    LDS_WAIT(); asm volatile("" ::: "memory");
}
template <int MODE>
__device__ __forceinline__ void transpose_item(const float* __restrict__ W, int K, int N, bf16* __restrict__ WT, LAS float* scr, int item, int lane) {
    TRef t; t.W = W; t.WT = WT; t.K = K; t.N = N; t.item = item; t.up = 0; float v[32]; titem_load(t, v, lane); titem_store<MODE>(t, v, scr, lane);
}
__device__ __forceinline__ void sincos_rev(double frac, double& s, double& c) {
    const double q = __builtin_rint(frac * 4.0); const double r = (frac - q * 0.25) * 6.283185307179586476925; const double r2 = r * r;
    double sp = -1.0 / 6227020800.0; sp = sp * r2 + 1.0 / 39916800.0; sp = sp * r2 - 1.0 / 362880.0; sp = sp * r2 + 1.0 / 5040.0; sp = sp * r2 - 1.0 / 120.0; sp = sp * r2 + 1.0 / 6.0; sp = r - r * r2 * sp;
    double cp = 1.0 / 479001600.0; cp = cp * r2 - 1.0 / 3628800.0; cp = cp * r2 + 1.0 / 40320.0; cp = cp * r2 - 1.0 / 720.0; cp = cp * r2 + 1.0 / 24.0; cp = cp * r2 - 0.5; cp = 1.0 + r2 * cp;
    const int qi = ((int)q) & 3;
    s = (qi == 0) ? sp : (qi == 1) ? cp : (qi == 2) ? -sp : -cp;
    c = (qi == 0) ? cp : (qi == 1) ? -sp : (qi == 2) ? -cp : sp;
}
__device__ __forceinline__ void sincos_rad(double ang, double& s, double& c) { const double rev = ang * 0.15915494309189533577; sincos_rev(rev - __builtin_rint(rev), s, c); }
__device__ __forceinline__ double exp_small(double x) {
    double p = 1.0 / 362880.0; p = p * x + 1.0 / 40320.0; p = p * x + 1.0 / 5040.0; p = p * x + 1.0 / 720.0; p = p * x + 1.0 / 120.0; p = p * x + 1.0 / 24.0; p = p * x + 1.0 / 6.0; p = p * x + 0.5; p = p * x + 1.0; return p * x + 1.0;
}
typedef __amdgpu_buffer_rsrc_t rsrc_t;
__device__ __forceinline__ rsrc_t mk_rsrc(const void* p, int bytes) { return __builtin_amdgcn_make_buffer_rsrc((void*)p, (short)0, bytes, 0x00020000); }
__device__ __forceinline__ f32x4 bl16(rsrc_t r, int voff, int soff) { return __builtin_bit_cast(f32x4, __builtin_amdgcn_raw_buffer_load_b128(r, voff, soff, 0)); }
__device__ __forceinline__ v2u bl8(rsrc_t r, int voff, int soff) { return __builtin_bit_cast(v2u, __builtin_amdgcn_raw_buffer_load_b64(r, voff, soff, 0)); }
__device__ __forceinline__ void bs16(f32x4 v, rsrc_t r, int voff, int soff) { __builtin_amdgcn_raw_buffer_store_b128(__builtin_bit_cast(v4u, v), r, voff, soff, 0); }
__device__ __forceinline__ void bs8(v2u v, rsrc_t r, int voff, int soff) { __builtin_amdgcn_raw_buffer_store_b64(v, r, voff, soff, 0); }
__device__ __forceinline__ void rms_row_to_bf16(const float* xrow, const float* gain, bf16* orow, int lane) {
    const int o16 = lane * 16, o8 = lane * 8;
    const rsrc_t rx = mk_rsrc(xrow, DM * 4), rg = mk_rsrc(gain, DM * 4), ro = mk_rsrc(orow, DM * 2);
    f32x4 v[16]; float ss = 0.f;
#pragma unroll
    for (int j = 0; j < 16; ++j) { v[j] = bl16(rx, o16, 1024 * j); ss += (v[j].x * v[j].x + v[j].y * v[j].y) + (v[j].z * v[j].z + v[j].w * v[j].w); }
    const float rstd = 1.f / sqrtf(wave_sum(ss) * (1.f / DM) + EPS);
#pragma unroll
    for (int j = 0; j < 16; ++j) { const f32x4 g = bl16(rg, o16, 1024 * j); v2u w; w.x = pk2(v[j].x * rstd * g.x, v[j].y * rstd * g.y); w.y = pk2(v[j].z * rstd * g.z, v[j].w * rstd * g.w); bs8(w, ro, o8, 512 * j); }
}

namespace att {
constexpr float SCALE = 0.088388347648318440f, CEXP = SCALE * 1.4426950408889634f;
#define KSWZ(row, colB) ((row) * 256 + ((colB) ^ (((row) & 7) << 4)))
__device__ __forceinline__ int crow(int r, int hi) { return (r & 3) + 8 * (r >> 2) + 4 * hi; }
__device__ __forceinline__ int v_st(int k, int c) { const int kk = (k & ~0xC) | ((k & 4) << 1) | ((k & 8) >> 1); return ((kk >> 3) * 4 + (c >> 5)) * 512 + ((kk & 7) * 32 + (c & 31)) * 2; }
__device__ __forceinline__ int v_rd_base(int lane) { return ((lane & 3) << 3) | (((lane >> 2) & 3) << 6) | (((lane >> 4) & 1) << 5) | (((lane >> 5) & 1) << 8); }
constexpr int v_rd_off(int d0, int ks, int half) { return d0 * 512 + ks * 4096 + half * 2048; }
template <int OFF> __device__ __forceinline__ s16x4 tr_read(int vb) {
    s16x4 r; asm volatile("ds_read_b64_tr_b16 %0, %1 offset:%2" : "=&v"(r) : "v"(vb), "i"(OFF) : "memory"); return r;
}
template <int D0> __device__ __forceinline__ void pv_one(f32x16& od, int vb, bf16x8 pa0, bf16x8 pa1, bf16x8 pa2, bf16x8 pa3) {
    const s16x4 l0 = tr_read<v_rd_off(D0, 0, 0)>(vb), h0 = tr_read<v_rd_off(D0, 0, 1)>(vb), l1 = tr_read<v_rd_off(D0, 1, 0)>(vb), h1 = tr_read<v_rd_off(D0, 1, 1)>(vb);
    const s16x4 l2 = tr_read<v_rd_off(D0, 2, 0)>(vb), h2 = tr_read<v_rd_off(D0, 2, 1)>(vb), l3 = tr_read<v_rd_off(D0, 3, 0)>(vb), h3 = tr_read<v_rd_off(D0, 3, 1)>(vb);
    asm volatile("s_waitcnt lgkmcnt(0)" ::: "memory"); __builtin_amdgcn_sched_barrier(0);
#define PK(L, H) (bf16x8){L[0], L[1], L[2], L[3], H[0], H[1], H[2], H[3]}
    od = __builtin_amdgcn_mfma_f32_32x32x16_bf16(pa0, PK(l0, h0), od, 0, 0, 0);
    od = __builtin_amdgcn_mfma_f32_32x32x16_bf16(pa1, PK(l1, h1), od, 0, 0, 0);
    od = __builtin_amdgcn_mfma_f32_32x32x16_bf16(pa2, PK(l2, h2), od, 0, 0, 0);
    od = __builtin_amdgcn_mfma_f32_32x32x16_bf16(pa3, PK(l3, h3), od, 0, 0, 0);
#undef PK
}
__device__ __forceinline__ void attn_unit(int uid, const bf16* __restrict__ Qg, const bf16* __restrict__ Kg, const bf16* __restrict__ Vg, bf16* __restrict__ PART, float* __restrict__ ML, LAS char* lds, int wid) {
    int lane = lane_id(); asm volatile("" : "+v"(lane));
    const int tid = wid * 64 + lane, r32 = lane & 31, hi = lane >> 5;
    const int pidx = uid >> 9, rem = uid & 511, bh = rem >> 3, sub = rem & 7, b = bh >> 4, h = bh & 15;
    const int dsh = 2 * pidx, d = 1 << dsh;
    int my_res, sub0, nt, tk0, tres0;
    if (pidx == 0)      { my_res = 0; sub0 = 256 * sub + 32 * wid; tres0 = 0; const int lo = 4 * sub - 1, hi_t = 4 * sub + 4; tk0 = lo < 0 ? 0 : lo; nt = (hi_t > 31 ? 31 : hi_t) - tk0 + 1; }
    else if (pidx == 1) { my_res = sub >> 1; const int blk = sub & 1; sub0 = 256 * blk + 32 * wid; tres0 = my_res; const int lo = 4 * blk - 1, hi_t = 4 * blk + 4; tk0 = lo < 0 ? 0 : lo; nt = (hi_t > 7 ? 7 : hi_t) - tk0 + 1; }
    else                { my_res = 2 * sub + (wid >> 2); sub0 = 32 * (wid & 3); tres0 = 2 * sub; tk0 = 0; nt = 4; }
    LAS char* K_lds = lds; LAS char* V_lds = lds + 16384; LAS float* al_l = (LAS float*)(lds + 32768) + wid * 64; LAS float* li_l = al_l + 32;
    const size_t tokb = (size_t)b * SEQ;
    bf16x8 qr[8];
    { const bf16* qp = Qg + (tokb + my_res + ((size_t)(sub0 + r32) << dsh)) * AW + h * HD + hi * 8;
#pragma unroll
      for (int d0 = 0; d0 < 8; ++d0) qr[d0] = *(const bf16x8*)(qp + d0 * 16); }
    float m_reg = -1e30f, l_reg = 0.f; f32x16 o[4];
#pragma unroll
    for (int d0 = 0; d0 < 4; ++d0) o[d0] = (f32x16){0.f, 0.f, 0.f, 0.f, 0.f, 0.f, 0.f, 0.f, 0.f, 0.f, 0.f, 0.f, 0.f, 0.f, 0.f, 0.f};
    const int sr = tid >> 4, sc = (tid & 15) * 8, vst0 = v_st(sr, sc), vst1 = v_st(32 + sr, sc);
    const int vb0 = (int)(unsigned)(uintptr_t)V_lds + v_rd_base(lane);
    bf16x8 gk0, gk1, gv0, gv1;
#define ATT_GLOAD(T) do { int tres_, ttk_; if (pidx == 2) { tres_ = tres0 + ((T) >> 1); ttk_ = (T) & 1; } else { tres_ = tres0; ttk_ = tk0 + (T); } \
        const size_t tok0 = tokb + tres_ + ((size_t)(64 * ttk_ + sr) << dsh), tok1 = tok0 + ((size_t)32 << dsh); \
        gk0 = *(const bf16x8*)(Kg + tok0 * AW + h * HD + sc); gk1 = *(const bf16x8*)(Kg + tok1 * AW + h * HD + sc); \
        gv0 = *(const bf16x8*)(Vg + tok0 * AW + h * HD + sc); gv1 = *(const bf16x8*)(Vg + tok1 * AW + h * HD + sc); } while (0)
    ATT_GLOAD(0);
    for (int t = 0; t < nt; ++t) {
        int tres, ttk; if (pidx == 2) { tres = tres0 + (t >> 1); ttk = t & 1; } else { tres = tres0; ttk = tk0 + t; }
        __syncthreads();
        *(LAS bf16x8*)(K_lds + KSWZ(sr, sc * 2)) = gk0; *(LAS bf16x8*)(K_lds + KSWZ(32 + sr, sc * 2)) = gk1;
        *(LAS bf16x8*)(V_lds + vst0) = gv0; *(LAS bf16x8*)(V_lds + vst1) = gv1;
        if (t + 1 < nt) ATT_GLOAD(t + 1);
        __syncthreads();
        const bool need = (tres == my_res) && (64 * ttk + 63 >= sub0 - 64) && (64 * ttk <= sub0 + 95);
        if (need) {
            f32x16 p0 = (f32x16){0.f, 0.f, 0.f, 0.f, 0.f, 0.f, 0.f, 0.f, 0.f, 0.f, 0.f, 0.f, 0.f, 0.f, 0.f, 0.f}, p1 = p0;
#pragma unroll
            for (int d0 = 0; d0 < 8; ++d0) { const int cb = (d0 * 16 + hi * 8) * 2;
                const bf16x8 b0 = *(const LAS bf16x8*)(K_lds + KSWZ(r32, cb)), b1 = *(const LAS bf16x8*)(K_lds + KSWZ(32 + r32, cb));
                p0 = __builtin_amdgcn_mfma_f32_32x32x16_bf16(b0, qr[d0], p0, 0, 0, 0);
                p1 = __builtin_amdgcn_mfma_f32_32x32x16_bf16(b1, qr[d0], p1, 0, 0, 0); }
            const int dk = 64 * ttk - (sub0 + r32);
            float pmax = -INFINITY;
#pragma unroll
            for (int r = 0; r < 16; ++r) { const int e0 = dk + crow(r, hi), e1 = e0 + 32;
                p0[r] = (e0 >= -64 && e0 <= 64) ? p0[r] : -INFINITY; p1[r] = (e1 >= -64 && e1 <= 64) ? p1[r] : -INFINITY;
                pmax = fmaxf(pmax, fmaxf(p0[r], p1[r])); }
            { auto rr = __builtin_amdgcn_permlane32_swap(__float_as_uint(pmax), __float_as_uint(pmax), false, false); pmax = fmaxf(__uint_as_float(rr[0]), __uint_as_float(rr[1])); }
            const float mn = fmaxf(m_reg, pmax), alpha = __builtin_amdgcn_exp2f((m_reg - mn) * CEXP); m_reg = mn;
            const float mnC = -mn * CEXP; float ps = 0.f;
#pragma unroll
            for (int r = 0; r < 16; ++r) { p0[r] = __builtin_amdgcn_exp2f(fmaf(p0[r], CEXP, mnC)); p1[r] = __builtin_amdgcn_exp2f(fmaf(p1[r], CEXP, mnC)); ps += p0[r] + p1[r]; }
            { auto rr = __builtin_amdgcn_permlane32_swap(__float_as_uint(ps), __float_as_uint(ps), false, false); ps = __uint_as_float(rr[0]) + __uint_as_float(rr[1]); }
            l_reg = l_reg * alpha + ps;
            if (hi == 0) al_l[r32] = alpha;
            asm volatile("s_waitcnt lgkmcnt(0)" ::: "memory");
#pragma unroll
            for (int r = 0; r < 16; ++r) { const float a = al_l[crow(r, hi)];
#pragma unroll
                for (int d0 = 0; d0 < 4; ++d0) o[d0][r] *= a; }
            bf16x8 pa0, pa1, pa2, pa3;
#define PK4(P, BASE, OUT) do { unsigned a0 = pk2(P[BASE + 0], P[BASE + 1]), a1 = pk2(P[BASE + 2], P[BASE + 3]);   \
    unsigned b0 = pk2(P[BASE + 4], P[BASE + 5]), b1 = pk2(P[BASE + 6], P[BASE + 7]);                              \
    auto r0 = __builtin_amdgcn_permlane32_swap(a0, b0, false, false); auto r1 = __builtin_amdgcn_permlane32_swap(a1, b1, false, false); \
    v4u w = {r0[0], r1[0], r0[1], r1[1]}; OUT = *reinterpret_cast<bf16x8*>(&w); } while (0)
            PK4(p0, 0, pa0); PK4(p0, 8, pa1); PK4(p1, 0, pa2); PK4(p1, 8, pa3);
#undef PK4
            pv_one<0>(o[0], vb0, pa0, pa1, pa2, pa3); pv_one<1>(o[1], vb0, pa0, pa1, pa2, pa3); pv_one<2>(o[2], vb0, pa0, pa1, pa2, pa3); pv_one<3>(o[3], vb0, pa0, pa1, pa2, pa3);
        }
    }
#undef ATT_GLOAD
    if (hi == 0) { li_l[r32] = l_reg; const size_t tq = tokb + my_res + ((size_t)(sub0 + r32) << dsh);
        float* mlp = ML + (((size_t)pidx * MTOK + tq) * AH + h) * 2; mlp[0] = m_reg; mlp[1] = l_reg; }
    asm volatile("s_waitcnt lgkmcnt(0)" ::: "memory");
    bf16* Pp = PART + (size_t)pidx * MTOK * AW + h * HD + r32;
#pragma unroll
    for (int r = 0; r < 16; ++r) { const int qi = crow(r, hi); const float rl = __builtin_amdgcn_rcpf(li_l[qi]);
        const size_t tq = tokb + my_res + ((size_t)(sub0 + qi) << dsh);
#pragma unroll
        for (int d0 = 0; d0 < 4; ++d0) Pp[tq * AW + d0 * 32] = (bf16)(pk2(o[d0][r] * rl, 0.f) & 0xffffu); }
    __syncthreads();
}
}

__device__ __forceinline__ void ssm_group(int g, const float* const* in, const float* __restrict__ ssmc, const bf16* __restrict__ U, float* __restrict__ Y0, float* __restrict__ Y1, bf16* __restrict__ Z, LAS char* lds, int wid) {
    int lane = lane_id(); asm volatile("" : "+v"(lane));
    const int n = lane & 31, hh = lane >> 5;
    const int dir = wid >> 2, b = wid & 3, dg = dir * NG + g;
        const float* b_re = in[11]; const float* b_im = in[12]; const float* c_re = in[13]; const float* c_im = in[14];
    LAS char* wl = lds + wid * SSM_WAVE_BYTES;
    LAS float* tab = (LAS float*)(wl + 4096);
    LAS v4u* bfl = (LAS v4u*)wl;
    {
        const f32x4 c0 = *(const f32x4*)(ssmc + ((size_t)dg * SP + lane) * 8); const f32x4 c1 = *(const f32x4*)(ssmc + ((size_t)dg * SP + lane) * 8 + 4);
        tab[lane] = c0[0]; tab[64 + lane] = c0[1]; tab[128 + lane] = c0[2]; tab[192 + lane] = c0[3]; tab[256 + lane] = c1[0]; tab[320 + lane] = c1[1];
    }
    LDS_WAIT();
    {
#pragma unroll
        for (int t = 0; t < 2; ++t) { const int ps = 32 * t + n; const float fr = tab[256 + ps], fi = tab[320 + ps];
            const f32x4* br = (const f32x4*)(b_re + ((size_t)dg * SP + ps) * SG + 8 * hh); const f32x4* bi = (const f32x4*)(b_im + ((size_t)dg * SP + ps) * SG + 8 * hh);
            const f32x4 r0 = br[0], r1 = br[1], i0 = bi[0], i1 = bi[1];
            const f32x4 re0 = fr * r0 - fi * i0, re1 = fr * r1 - fi * i1, im0 = fr * i0 + fi * r0, im1 = fr * i1 + fi * r1;
            v4u wr_; wr_.x = pk2(re0[0], re0[1]); wr_.y = pk2(re0[2], re0[3]); wr_.z = pk2(re1[0], re1[1]); wr_.w = pk2(re1[2], re1[3]);
            v4u wi_; wi_.x = pk2(im0[0], im0[1]); wi_.y = pk2(im0[2], im0[3]); wi_.z = pk2(im1[0], im1[1]); wi_.w = pk2(im1[2], im1[3]);
            bfl[t * 64 + lane] = wr_; bfl[(2 + t) * 64 + lane] = wi_; }
    }
    float ar0[16], ai0[16], ar1[16], ai1[16];
#pragma unroll
    for (int i = 0; i < 16; ++i) { const int p = att::crow(i, hh); ar0[i] = tab[p]; ai0[i] = tab[64 + p]; ar1[i] = tab[32 + p]; ai1[i] = tab[96 + p]; }
    const float aTr = tab[128 + lane], aTi = tab[192 + lane];
    LDS_WAIT();
    const bf16* ub = U + ((size_t)g * MTOK + (size_t)b * SEQ) * SG + 8 * hh;
    const long ustep = dir ? -(long)SG : (long)SG;
    const bf16* up0 = ub + (size_t)(dir ? (SEQ - 1 - 64 * n) : 64 * n) * SG;
    const f32x16 zero16 = (f32x16){0.f, 0.f, 0.f, 0.f, 0.f, 0.f, 0.f, 0.f, 0.f, 0.f, 0.f, 0.f, 0.f, 0.f, 0.f, 0.f};
    f32x16 H0 = zero16, H1 = zero16, H2 = zero16, H3 = zero16;
#define SSM_HALF(Ha, Hb, ar_, ai_, Bfa, Bfb, uvec) do { f32x16 Ra, Rb; \
    _Pragma("unroll") for (int i = 0; i < 16; ++i) { Ra[i] = ar_[i] * Ha[i] - ai_[i] * Hb[i]; Rb[i] = ar_[i] * Hb[i] + ai_[i] * Ha[i]; } \
    Ha = __builtin_amdgcn_mfma_f32_32x32x16_bf16(Bfa, uvec, Ra, 0, 0, 0); Hb = __builtin_amdgcn_mfma_f32_32x32x16_bf16(Bfb, uvec, Rb, 0, 0, 0); } while (0)
#define SSM_BF(t) (*(const LAS bf16x8*)(wl + ((t) * 64 + lane) * 16))
#define SSM_STEP(uvec) do { SSM_HALF(H0, H2, ar0, ai0, SSM_BF(0), SSM_BF(2), uvec); __builtin_amdgcn_sched_barrier(0); SSM_HALF(H1, H3, ar1, ai1, SSM_BF(1), SSM_BF(3), uvec); __builtin_amdgcn_sched_barrier(0); } while (0)
    {
        const bf16* up = up0;
        bf16x8 ua0 = *(const bf16x8*)up, ua1 = *(const bf16x8*)(up + ustep);
#pragma unroll 1
        for (int s = 0; s < 64; s += 2) {
            const bf16x8 n0 = *(const bf16x8*)(up + ((s + 2) & 63) * ustep), n1 = *(const bf16x8*)(up + ((s + 3) & 63) * ustep);
            SSM_STEP(ua0); SSM_STEP(ua1);
            ua0 = n0; ua1 = n1;
        }
    }
#define SSM_SCAN(Ha, Hb, FIRST) do { \
    _Pragma("unroll") for (int i = 0; i < 16; ++i) { const int r = att::crow(i, hh); tab[n * 65 + r] = Ha[i]; tab[n * 65 + 32 + r] = Hb[i]; } \
    LDS_WAIT(); \
    if ((lane < 32) == (FIRST)) { const int col = lane & 31; float cr = 0.f, ci = 0.f; \
        for (int k = 0; k < 32; ++k) { const float sr = tab[k * 65 + col], si = tab[k * 65 + 32 + col]; \
            tab[k * 65 + col] = cr; tab[k * 65 + 32 + col] = ci; \
            const float nr = aTr * cr - aTi * ci + sr, ni = aTr * ci + aTi * cr + si; cr = nr; ci = ni; } } \
    LDS_WAIT(); \
    _Pragma("unroll") for (int i = 0; i < 16; ++i) { const int r = att::crow(i, hh); Ha[i] = tab[n * 65 + r]; Hb[i] = tab[n * 65 + 32 + r]; } \
    LDS_WAIT(); } while (0)
    SSM_SCAN(H0, H2, true);
    SSM_SCAN(H1, H3, false);
#undef SSM_SCAN
    {
        LAS v4u* ctab = (LAS v4u*)tab;
        int c = n; asm volatile("" : "+v"(c));
        int hq = hh; asm volatile("" : "+v"(hq));
#pragma unroll
        for (int t = 0; t < 4; ++t)
#pragma unroll
            for (int s2 = 0; s2 < 2; ++s2) { float e[8];
#pragma unroll
                for (int j = 0; j < 8; ++j) { const int rho = 16 * s2 + 8 * (j >> 2) + 4 * hq + (j & 3), pp = 32 * (t & 1) + rho;
                    float v = 0.f; if (c < 16) v = (t < 2) ? c_re[((size_t)dg * SG + c) * SP + pp] : -c_im[((size_t)dg * SG + c) * SP + pp]; e[j] = v; }
                v4u w; w.x = pk2(e[0], e[1]); w.y = pk2(e[2], e[3]); w.z = pk2(e[4], e[5]); w.w = pk2(e[6], e[7]); ctab[(t * 2 + s2) * 64 + lane] = w; }
    }
    LDS_WAIT();
    {
        const LAS bf16x8* ctab = (const LAS bf16x8*)tab;
        float* Y = dir ? Y1 : Y0;
        float* yp = Y + (((size_t)g * MTOK + (size_t)b * SEQ + (dir ? (SEQ - 1 - 64 * n) : 64 * n)) * SG) + 4 * hh;
        const long ystep = dir ? -(long)SG : (long)SG;
        const bf16* up = up0;
#define SSM_CPROJ(Ht, t) do { \
    v4u w0; w0.x = pk2(Ht[0], Ht[1]); w0.y = pk2(Ht[2], Ht[3]); w0.z = pk2(Ht[4], Ht[5]); w0.w = pk2(Ht[6], Ht[7]); \
    v4u w1; w1.x = pk2(Ht[8], Ht[9]); w1.y = pk2(Ht[10], Ht[11]); w1.z = pk2(Ht[12], Ht[13]); w1.w = pk2(Ht[14], Ht[15]); \
    Yc = __builtin_amdgcn_mfma_f32_32x32x16_bf16(ctab[((t) * 2 + 0) * 64 + lane], *reinterpret_cast<bf16x8*>(&w0), Yc, 0, 0, 0); \
    Yc = __builtin_amdgcn_mfma_f32_32x32x16_bf16(ctab[((t) * 2 + 1) * 64 + lane], *reinterpret_cast<bf16x8*>(&w1), Yc, 0, 0, 0); } while (0)
#define SSM_OUT(sidx) do { f32x16 Yc = zero16; SSM_CPROJ(H0, 0); SSM_CPROJ(H1, 1); SSM_CPROJ(H2, 2); SSM_CPROJ(H3, 3); \
    float* yq = yp + (sidx) * ystep; *(f32x4*)yq = (f32x4){Yc[0], Yc[1], Yc[2], Yc[3]}; *(f32x4*)(yq + 8) = (f32x4){Yc[4], Yc[5], Yc[6], Yc[7]}; } while (0)
        bf16x8 ua0 = *(const bf16x8*)up, ua1 = *(const bf16x8*)(up + ustep);
#pragma unroll 1
        for (int s = 0; s < 64; s += 2) {
            const bf16x8 n0 = *(const bf16x8*)(up + ((s + 2) & 63) * ustep), n1 = *(const bf16x8*)(up + ((s + 3) & 63) * ustep);
            SSM_STEP(ua0); SSM_OUT(s); SSM_STEP(ua1); SSM_OUT(s + 1);
            ua0 = n0; ua1 = n1;
        }
#undef SSM_OUT
#undef SSM_CPROJ
    }
#undef SSM_STEP
#undef SSM_HALF
#undef SSM_BF
    VM_WAIT(); __syncthreads();
    {
        const float* dsk = in[15]; const int tid = wid * 64 + lane;
#pragma unroll 4
        for (int i = tid; i < MTOK * 2; i += NWAVES * 64) {
            const int row = i >> 1, c8 = (i & 1) * 8; const size_t goff = ((size_t)g * MTOK + row) * SG + c8;
            const v4u uu = *(const v4u*)(U + goff); const f32x4 d0 = *(const f32x4*)(dsk + g * SG + c8), d1 = *(const f32x4*)(dsk + g * SG + c8 + 4);
            const f32x4 a0 = *(const f32x4*)(Y0 + goff), a1 = *(const f32x4*)(Y0 + goff + 4), b0 = *(const f32x4*)(Y1 + goff), b1 = *(const f32x4*)(Y1 + goff + 4);
            v4u z; z.x = pk2(gelu_tanh(d0[0] * bflo(uu.x) + a0[0] + b0[0]), gelu_tanh(d0[1] * bfhi(uu.x) + a0[1] + b0[1]));
            z.y = pk2(gelu_tanh(d0[2] * bflo(uu.y) + a0[2] + b0[2]), gelu_tanh(d0[3] * bfhi(uu.y) + a0[3] + b0[3]));
            z.z = pk2(gelu_tanh(d1[0] * bflo(uu.z) + a1[0] + b1[0]), gelu_tanh(d1[1] * bfhi(uu.z) + a1[1] + b1[1]));
            z.w = pk2(gelu_tanh(d1[2] * bflo(uu.w) + a1[2] + b1[2]), gelu_tanh(d1[3] * bfhi(uu.w) + a1[3] + b1[3]));
            *(v4u*)(Z + (size_t)row * SW + g * SG + c8) = z;
        }
    }
}


#ifndef TAP
#define TAP 0
#endif
#define TAP_FILL(EXPR) do { xcd_barrier(bar); { PHASE_IDS(); for (size_t i = (size_t)bx * 512 + tid; i < (size_t)MTOK * DM; i += (size_t)G * 512) { const size_t r = i >> 12; const int c = (int)(i & 4095); (void)r; (void)c; out[i] = (EXPR); } } return; } while (0)
__device__ __forceinline__ float bf2f(bf16 v) { return __uint_as_float(((unsigned)v) << 16); }
struct Args { const float* in[27]; float* out; unsigned char* ws; };
__global__ void __launch_bounds__(NWAVES * 64, 2) hybrid_fwd(Args args) {
    extern __shared__ __attribute__((aligned(16))) unsigned char lds_raw[];
    LAS unsigned char* lds = (LAS unsigned char*)lds_raw;
    volatile LAS unsigned* MISC = (volatile LAS unsigned*)(lds + MISC_OFF);
    const int wave = __builtin_amdgcn_readfirstlane((int)threadIdx.x >> 6);
#define PHASE_IDS() int lane = lane_id(); asm volatile("" : "+v"(lane)); const int tid = wave * 64 + lane; const int gw = vcu * NWAVES + wave; (void)tid; (void)gw
    const int G = gridDim.x, bx = blockIdx.x;
    const int vcu = (G % 8 == 0) ? (bx % 8) * (G / 8) + bx / 8 : bx;
    unsigned char* ws = args.ws;
    for (int u = threadIdx.x; u < (LDS_BYTES - MISC_OFF) / 4; u += NWAVES * 64) ((LAS unsigned*)(lds + MISC_OFF))[u] = 0u;
    __syncthreads();
    XcdBarrier bar = xcd_barrier_post((unsigned*)(ws + WS_CTL) + CW_BAR, MISC + 8, wave);
    const int NGW = G * NWAVES;

    bf16* WIN = (bf16*)(ws + WS_WIN); bf16* WA = (bf16*)(ws + WS_WA); bf16* WB = (bf16*)(ws + WS_WB); bf16* WOUT = (bf16*)(ws + WS_WOUT); bf16* WGLU = (bf16*)(ws + WS_WGLU);
    bf16* WUP = (bf16*)(ws + WS_WUP); bf16* WDOWN = (bf16*)(ws + WS_WDOWN); bf16* WPLE = (bf16*)(ws + WS_WPLE); bf16* WPG = (bf16*)(ws + WS_WPG);
    bf16* XN = (bf16*)(ws + WS_XN); bf16* PLEB = (bf16*)(ws + WS_PLEB); bf16* OUT1 = (bf16*)(ws + WS_OUT1);
    bf16* Qb = (bf16*)(ws + WS_Q); bf16* Kb = (bf16*)(ws + WS_K); bf16* Vb = (bf16*)(ws + WS_V); bf16* Ub = (bf16*)(ws + WS_U); bf16* GAb = (bf16*)(ws + WS_GA); bf16* GBb = (bf16*)(ws + WS_GB);
    bf16* PART = (bf16*)(ws + WS_PART); float* ML = (float*)(ws + WS_ML); float* Y0 = (float*)(ws + WS_Y0); float* Y1 = (float*)(ws + WS_Y1);
    bf16* YA = (bf16*)(ws + WS_YA); bf16* Zb = (bf16*)(ws + WS_Z); bf16* YB = (bf16*)(ws + WS_YB); bf16* TMP = (bf16*)(ws + WS_TMP);
    float* EA = (float*)(ws + WS_EA); float* EB = (float*)(ws + WS_EB); bf16* ACT = (bf16*)(ws + WS_ACT);
    bf16* PB = (bf16*)(ws + WS_PB); float* ROPE = (float*)(ws + WS_ROPE); float* RPLE = (float*)(ws + WS_RPLE); float* SSMC = (float*)(ws + WS_SSMC);
    float* out = args.out; const float* x = args.in[0];

    {
        PHASE_IDS();
        LAS float* scr = (LAS float*)(lds + RING_OFF + wave * 16384);
        constexpr int I_IN = 64 * 512, I_PLE = 4 * 128;
        for (int it = gw; it < I_IN + I_PLE; it += NGW) {
            if (it < I_IN) transpose_item<1>(args.in[4], DM, INW, WIN, scr, it, lane);
            else transpose_item<0>(args.in[24], PLED, DM, WPLE, scr, it - I_IN, lane);
        }
        for (int m = gw; m < MTOK; m += NGW) rms_row_to_bf16(x + (size_t)m * DM, args.in[2], XN + (size_t)m * DM, lane);
        { const float* p = args.in[1];
          for (int i = bx * 512 + tid; i < MTOK * PLED / 8; i += G * 512) { const f32x4 a = *(const f32x4*)(p + (size_t)i * 8), c = *(const f32x4*)(p + (size_t)i * 8 + 4);
              v4u w; w.x = pk2(a[0], a[1]); w.y = pk2(a[2], a[3]); w.z = pk2(c[0], c[1]); w.w = pk2(c[2], c[3]); *(v4u*)(PB + (size_t)i * 8) = w; } }
        for (int i = bx * 512 + tid; i < 2 * NG * SP; i += G * 512) {
            const double lr = (double)args.in[8][i], li = (double)args.in[9][i], dt = (double)expf(args.in[10][i >> 6]);
            const double mag = exp_small(lr * dt); double s, c; sincos_rad(li * dt, s, c);
            const double ar = mag * c, ai = mag * s, den = lr * lr + li * li;
            const double fr = ((ar - 1.0) * lr + ai * li) / den, fi = (ai * lr - (ar - 1.0) * li) / den;
            const double magT = (double)expf((float)(lr * dt * 64.0)); double sT, cT; sincos_rad(li * dt * 64.0, sT, cT);
            *(f32x4*)(SSMC + (size_t)i * 8) = (f32x4){(float)ar, (float)ai, (float)(magT * cT), (float)(magT * sT)}; *(f32x4*)(SSMC + (size_t)i * 8 + 4) = (f32x4){(float)fr, (float)fi, 0.f, 0.f}; }
        for (int i = bx * 512 + tid; i < SEQ * 64; i += G * 512) { const int pos = i >> 6, f = i & 63;
            const float inv = exp2f(-(float)(2 * f) * (1.f / 128.f) * 13.287712379549449f);
            const float ang = (float)pos * inv; double s, c; sincos_rad((double)ang, s, c);
            ROPE[(size_t)pos * 128 + f] = (float)c; ROPE[(size_t)pos * 128 + 64 + f] = (float)s; }
    }
    xcd_barrier(bar);

    {
        pg8::Gemm g{XN, WIN, MTOK, INW, DM}; pg8::StaticOrder S; S.init(MTOK, INW, G, bx);
        EpiIn E{Qb, Kb, Vb, Ub, GAb, GBb, ROPE};
        pg8::gemm_phase<EpiIn, pg8::StaticOrder, true, true>(lds + RING_OFF, g, S, E, wave);
    }
    {
        pg8::Gemm g{PB, WPLE, MTOK, DM, PLED}; pg8::StaticOrder S; S.init(MTOK, DM, G, bx);
        EpiPlain E{PLEB, DM, 0, 0};
        pg8::gemm_phase<EpiPlain, pg8::StaticOrder, true, true>(lds + RING_OFF, g, S, E, wave);
    }
#if TAP == 11
    TAP_FILL(bf2f(GAb[i]) + bf2f(GBb[i]));
#endif
#if TAP == 12
    TAP_FILL(bf2f(PLEB[i]));
#endif
#if TAP == 1
    TAP_FILL(bf2f(Qb[r * 2048 + (c & 2047)]) + bf2f(Kb[r * 2048 + (c & 2047)]) + bf2f(Vb[r * 2048 + (c & 2047)]) + bf2f(Ub[r * 2048 + (c & 2047)]) + bf2f(GAb[i]) + bf2f(GBb[i]) + bf2f(PLEB[i]));
#endif
    xcd_barrier(bar);

    {
        constexpr int I_A = 32 * 128, I_OUT = 64 * 128, I_GLU = 32 * 64, I_UP = 64 * 768, I_DOWN = 192 * 128;
        constexpr int NCONVW = I_UP + I_DOWN + 2 * I_A + 2 * I_OUT + I_GLU, NCONV = NCONVW / 64, NATT = 1536, NITEM = NG + NCONV + NATT;
        static_assert(NCONVW % 64 == 0 && NCONV >= NATT, "conversion items");
        unsigned* qctr = (unsigned*)(ws + WS_CTL) + CW_QUEUE;
        volatile LAS unsigned* qslot = MISC + 16;
        const bool t0 = (wave == 0 && lane_id() == 0);
        unsigned nxt = 0u; if (t0) nxt = __hip_atomic_fetch_add(qctr, 1u, __ATOMIC_RELAXED, __HIP_MEMORY_SCOPE_AGENT);
        for (;;) {
            __syncthreads();
            if (t0) *qslot = nxt;
            __syncthreads();
            const int w = __builtin_amdgcn_readfirstlane((int)*qslot);
            if (w >= NITEM) break;
            if (t0) nxt = __hip_atomic_fetch_add(qctr, 1u, __ATOMIC_RELAXED, __HIP_MEMORY_SCOPE_AGENT);
            if (w < NG) { ssm_group(w, args.in, SSMC, Ub, Y0, Y1, Zb, (LAS char*)lds, wave); continue; }
            const int k = w - NG; int cv = -1, au = -1;
            if (k < 2 * NATT) { if (k & 1) au = k >> 1; else cv = k >> 1; } else cv = k - NATT;
            if (au >= 0) { att::attn_unit(au, Qb, Kb, Vb, PART, ML, (LAS char*)lds, wave); continue; }
            {
                int lane = lane_id(); asm volatile("" : "+v"(lane));
                LAS float* scr = (LAS float*)(lds + RING_OFF + wave * 16384);
                auto ref = [&](int j) { TRef t; int r = cv * 64 + j * 8 + wave;
                    t.up = 0; if (r < I_UP) { t.W = args.in[20]; t.WT = WUP; t.K = DM; t.N = 2 * DFF; t.item = r; t.up = 1; return t; } r -= I_UP;
                    if (r < I_DOWN) { t.W = args.in[23]; t.WT = WDOWN; t.K = DFF; t.N = DM; t.item = r; return t; } r -= I_DOWN;
                    if (r < I_A) { t.W = args.in[5]; t.WT = WA; t.K = AW; t.N = DM; t.item = r; return t; } r -= I_A;
                    if (r < I_A) { t.W = args.in[6]; t.WT = WB; t.K = SW; t.N = DM; t.item = r; return t; } r -= I_A;
                    if (r < I_OUT) { t.W = args.in[7]; t.WT = WOUT; t.K = DM; t.N = DM; t.item = r; return t; } r -= I_OUT;
                    if (r < I_GLU) { t.W = args.in[16]; t.WT = WGLU; t.K = SW; t.N = SW; t.item = r; return t; } r -= I_GLU;
                    t.W = args.in[26]; t.WT = WPG; t.K = DM; t.N = DM; t.item = r; return t; };
                float va[32], vb[32];
                TRef ta = ref(0), tb; titem_load(ta, va, lane);
#pragma unroll 1
                for (int j = 0; j < 8; j += 2) {
                    tb = ref(j + 1); titem_load(tb, vb, lane);
                    if (ta.up) titem_store<2>(ta, va, scr, lane); else titem_store<0>(ta, va, scr, lane);
                    if (j + 2 < 8) { ta = ref(j + 2); titem_load(ta, va, lane); }
                    if (tb.up) titem_store<2>(tb, vb, scr, lane); else titem_store<0>(tb, vb, scr, lane);
                }
            }
        }
    }
    xcd_barrier(bar);

    {
        PHASE_IDS();
        for (int i = bx * 512 + tid; i < MTOK * AW / 8; i += G * 512) {
            const int tok = i >> 8, c8 = (i & 255) * 8, h = c8 >> 7;
            float m[3], l[3];
#pragma unroll
            for (int p = 0; p < 3; ++p) { const float* mp = ML + (((size_t)p * MTOK + tok) * AH + h) * 2; m[p] = mp[0]; l[p] = mp[1]; }
            const float mm = fmaxf(m[0], fmaxf(m[1], m[2]));
            float w[3]; float ws_ = 0.f;
#pragma unroll
            for (int p = 0; p < 3; ++p) { w[p] = __builtin_amdgcn_exp2f((m[p] - mm) * att::CEXP) * l[p]; ws_ += w[p]; }
            const float rw = 1.f / ws_;
            float acc[8] = {0.f, 0.f, 0.f, 0.f, 0.f, 0.f, 0.f, 0.f};
#pragma unroll
            for (int p = 0; p < 3; ++p) { const v4u q = *(const v4u*)(PART + ((size_t)p * MTOK + tok) * AW + c8); const float wp = w[p] * rw;
                acc[0] += wp * bflo(q.x); acc[1] += wp * bfhi(q.x); acc[2] += wp * bflo(q.y); acc[3] += wp * bfhi(q.y); acc[4] += wp * bflo(q.z); acc[5] += wp * bfhi(q.z); acc[6] += wp * bflo(q.w); acc[7] += wp * bfhi(q.w); }
            v4u o; o.x = pk2(acc[0], acc[1]); o.y = pk2(acc[2], acc[3]); o.z = pk2(acc[4], acc[5]); o.w = pk2(acc[6], acc[7]);
            *(v4u*)(YA + (size_t)tok * AW + c8) = o;
        }
    }
#if TAP == 2
    TAP_FILL(bf2f(YA[r * 2048 + (c & 2047)]) + bf2f(Zb[r * 2048 + (c & 2047)]));
#endif
#if TAP == 21
    TAP_FILL(bf2f(YA[r * 2048 + (c & 2047)]));
#endif
#if TAP == 22
    TAP_FILL(bf2f(Zb[r * 2048 + (c & 2047)]));
#endif
    xcd_barrier(bar);

    {
        pg8::Gemm g{Zb, WGLU, MTOK, SW, SW}; pg8::StaticOrder S; S.init(MTOK, SW, G, bx);
        EpiGlu E{Zb, YB, args.in[17]};
        pg8::gemm_phase<EpiGlu, pg8::StaticOrder, true, true>(lds + RING_OFF, g, S, E, wave);
    }
#if TAP == 30
    TAP_FILL(bf2f(YB[r * 2048 + (c & 2047)]));
#endif
    xcd_barrier(bar);

    {
        pg8::Gemm g{YA, WA, MTOK, DM, AW}; pg8::StaticOrder S; S.init(MTOK, DM, G, bx);
        EpiGate<true> E{GAb, TMP};
        pg8::gemm_phase<EpiGate<true>, pg8::StaticOrder, true, true>(lds + RING_OFF, g, S, E, wave);
    }
#if TAP == 31
    TAP_FILL(bf2f(TMP[i]));
#endif
    VM_WAIT(); __syncthreads();
    {
        pg8::Gemm g{YB, WB, MTOK, DM, SW}; pg8::StaticOrder S; S.init(MTOK, DM, G, bx);
        EpiGate<false> E{GBb, TMP};
        pg8::gemm_phase<EpiGate<false>, pg8::StaticOrder, true, true>(lds + RING_OFF, g, S, E, wave);
    }
#if TAP == 3
    TAP_FILL(bf2f(TMP[i]) + bf2f(YB[r * 2048 + (c & 2047)]));
#endif
    xcd_barrier(bar);

    {
        pg8::Gemm g{TMP, WOUT, MTOK, DM, DM}; pg8::StaticOrder S; S.init(MTOK, DM, G, bx);
        EpiPlain E{OUT1, DM, 0, 0};
        pg8::gemm_phase<EpiPlain, pg8::StaticOrder, true, true>(lds + RING_OFF, g, S, E, wave);
    }
    xcd_barrier(bar);

    { PHASE_IDS();
    const int o16 = lane * 16, o8 = lane * 8;
    const rsrc_t rg1 = mk_rsrc(args.in[3], DM * 4), rg2 = mk_rsrc(args.in[18], DM * 4);
    for (int m = gw; m < MTOK; m += NGW) {
        const rsrc_t ro = mk_rsrc(OUT1 + (size_t)m * DM, DM * 2), rx = mk_rsrc(x + (size_t)m * DM, DM * 4), rh = mk_rsrc(out + (size_t)m * DM, DM * 4), rn = mk_rsrc(XN + (size_t)m * DM, DM * 2);
        f32x4 v[16]; float ss = 0.f;
#pragma unroll
        for (int j = 0; j < 16; ++j) { const v2u w = bl8(ro, o8, 512 * j); v[j] = (f32x4){bflo(w.x), bfhi(w.x), bflo(w.y), bfhi(w.y)}; ss += (v[j].x * v[j].x + v[j].y * v[j].y) + (v[j].z * v[j].z + v[j].w * v[j].w); }
        const float rstd = 1.f / sqrtf(wave_sum(ss) * (1.f / DM) + EPS); float s2 = 0.f;
#pragma unroll
        for (int j = 0; j < 16; ++j) { const f32x4 g = bl16(rg1, o16, 1024 * j); v[j] = bl16(rx, o16, 1024 * j) + v[j] * rstd * g; s2 += (v[j].x * v[j].x + v[j].y * v[j].y) + (v[j].z * v[j].z + v[j].w * v[j].w); }
        const float rstd2 = 1.f / sqrtf(wave_sum(s2) * (1.f / DM) + EPS);
#pragma unroll
        for (int j = 0; j < 16; ++j) { bs16(v[j], rh, o16, 1024 * j); const f32x4 g = bl16(rg2, o16, 1024 * j); v2u w; w.x = pk2(v[j].x * rstd2 * g.x, v[j].y * rstd2 * g.y); w.y = pk2(v[j].z * rstd2 * g.z, v[j].w * rstd2 * g.w); bs8(w, rn, o8, 512 * j); }
    } }
#if TAP == 4
    TAP_FILL(out[i] + bf2f(XN[i]));
#endif
    xcd_barrier(bar);

    {
        pg8::Gemm g{XN, WUP, MTOK, 2 * DFF, DM}; pg8::StaticOrder S; S.init(MTOK, 2 * DFF, G, bx);
        EpiUp E{ACT, EA, EB, args.in[21], args.in[22]};
        pg8::gemm_phase<EpiUp, pg8::StaticOrder, true, true>(lds + RING_OFF, g, S, E, wave);
    }
    xcd_barrier(bar);

    {
        PHASE_IDS();
        const float* cw = args.in[21]; const float* cb = args.in[22];
        constexpr int NC4 = DFF / 4;
        for (int i = bx * 512 + tid; i < 128 * 2 * NC4; i += G * 512) {
            const int c4 = (i % NC4) * 4, rs = (i / NC4) & 1, blk = i / (2 * NC4), R = blk * 64 + (rs ? 63 : 0), t = R & (SEQ - 1);
            const f32x4 zero4 = (f32x4){0.f, 0.f, 0.f, 0.f};
            f32x4 prev, cur, next, bv;
            if (!rs) { cur = *(const f32x4*)(EA + ((size_t)blk * 4 + 0) * DFF + c4); next = *(const f32x4*)(EA + ((size_t)blk * 4 + 1) * DFF + c4);
                       prev = t == 0 ? zero4 : *(const f32x4*)(EA + ((size_t)(blk - 1) * 4 + 3) * DFF + c4); bv = *(const f32x4*)(EB + ((size_t)blk * 2) * DFF + c4); }
            else     { cur = *(const f32x4*)(EA + ((size_t)blk * 4 + 3) * DFF + c4); prev = *(const f32x4*)(EA + ((size_t)blk * 4 + 2) * DFF + c4);
                       next = t == SEQ - 1 ? zero4 : *(const f32x4*)(EA + ((size_t)(blk + 1) * 4 + 0) * DFF + c4); bv = *(const f32x4*)(EB + ((size_t)blk * 2 + 1) * DFF + c4); }
            const f32x4 w0 = *(const f32x4*)(cw + c4), w1 = *(const f32x4*)(cw + DFF + c4), w2 = *(const f32x4*)(cw + 2 * DFF + c4), bs = *(const f32x4*)(cb + c4);
            float o[4];
#pragma unroll
            for (int e = 0; e < 4; ++e) o[e] = gelu_tanh(bs[e] + w0[e] * prev[e] + w1[e] * cur[e] + w2[e] * next[e]) * bv[e];
            v2u w; w.x = pk2(o[0], o[1]); w.y = pk2(o[2], o[3]);
            *(v2u*)(ACT + (size_t)R * DFF + c4) = w;
        }
    }
#if TAP == 5
    TAP_FILL(bf2f(ACT[r * DFF + c]) + bf2f(ACT[r * DFF + 4096 + c]) + bf2f(ACT[r * DFF + 8192 + c]));
#endif
    xcd_barrier(bar);

    {
        pg8::Gemm g{ACT, WDOWN, MTOK, DM, DFF}; pg8::StaticOrder S; S.init(MTOK, DM, G, bx);
        EpiPlain E{OUT1, DM, 0, 0};
        pg8::gemm_phase<EpiPlain, pg8::StaticOrder, true, true>(lds + RING_OFF, g, S, E, wave);
    }
    xcd_barrier(bar);

    { PHASE_IDS();
    const int o16 = lane * 16, o8 = lane * 8;
    const rsrc_t rg1 = mk_rsrc(args.in[19], DM * 4);
    for (int m = gw; m < MTOK; m += NGW) {
        const rsrc_t ro = mk_rsrc(OUT1 + (size_t)m * DM, DM * 2), rh = mk_rsrc(out + (size_t)m * DM, DM * 4), rn = mk_rsrc(XN + (size_t)m * DM, DM * 2), rp_ = mk_rsrc(PLEB + (size_t)m * DM, DM * 2);
        f32x4 v[16]; float ss = 0.f;
#pragma unroll
        for (int j = 0; j < 16; ++j) { const v2u w = bl8(ro, o8, 512 * j); v[j] = (f32x4){bflo(w.x), bfhi(w.x), bflo(w.y), bfhi(w.y)}; ss += (v[j].x * v[j].x + v[j].y * v[j].y) + (v[j].z * v[j].z + v[j].w * v[j].w); }
        const float rstd = 1.f / sqrtf(wave_sum(ss) * (1.f / DM) + EPS);
#pragma unroll
        for (int j = 0; j < 16; ++j) { const f32x4 g = bl16(rg1, o16, 1024 * j); const f32x4 hv = bl16(rh, o16, 1024 * j) + v[j] * rstd * g; bs16(hv, rh, o16, 1024 * j); v2u w; w.x = pk2(hv.x, hv.y); w.y = pk2(hv.z, hv.w); bs8(w, rn, o8, 512 * j); }
        float sp = 0.f;
#pragma unroll
        for (int j = 0; j < 16; ++j) { const v2u w = bl8(rp_, o8, 512 * j); const float a = bflo(w.x), b = bfhi(w.x), c = bflo(w.y), d = bfhi(w.y); sp += (a * a + b * b) + (c * c + d * d); }
        const float rp = 1.f / sqrtf(wave_sum(sp) * (1.f / DM) + EPS);
        if (lane == 0) RPLE[m] = rp;
    } }
#if TAP == 6
    TAP_FILL(out[i] + bf2f(XN[i]) + RPLE[r]);
#endif
    xcd_barrier(bar);

    {
        pg8::Gemm g{XN, WPG, MTOK, DM, DM}; pg8::StaticOrder S; S.init(MTOK, DM, G, bx);
        EpiFinal E{out, PLEB, RPLE, args.in[25]};
        pg8::gemm_phase<EpiFinal, pg8::StaticOrder, true, true>(lds + RING_OFF, g, S, E, wave);
    }
}

extern "C" void kernel_launch(void* const* d_in, const int* in_sizes, int n_in, void* d_out, int out_size, void* d_ws, size_t ws_size, hipStream_t stream) {
    static int grid = 0;
    if (grid == 0) {
        if (n_in != 27 || out_size != MTOK * DM || ws_size < WS_END) { fprintf(stderr, "kernel_launch: unexpected shapes: n_in %d out %d ws %zu (need >= %zu)\n", n_in, out_size, ws_size, (size_t)WS_END); grid = -1; return; }
        int dev = 0, cus = 0, per_cu = 0;
        if (hipGetDevice(&dev) != hipSuccess || hipDeviceGetAttribute(&cus, hipDeviceAttributeMultiprocessorCount, dev) != hipSuccess) { grid = -1; return; }
        if (hipFuncSetAttribute((const void*)hybrid_fwd, hipFuncAttributeMaxDynamicSharedMemorySize, LDS_BYTES) != hipSuccess) { fprintf(stderr, "kernel_launch: hipFuncSetAttribute failed\n"); grid = -1; return; }
        if (hipOccupancyMaxActiveBlocksPerMultiprocessor(&per_cu, (const void*)hybrid_fwd, NWAVES * 64, LDS_BYTES) != hipSuccess || per_cu < 1)
            fprintf(stderr, "kernel_launch: note: occupancy query reports %d workgroups per CU\n", per_cu);
        (void)hipGetLastError();
        grid = cus;
    }
    if (grid < 0) return;
    if (hipMemsetAsync((char*)d_ws + WS_CTL, 0, CTL_ZERO_BYTES, stream) != hipSuccess) { fprintf(stderr, "kernel_launch: memset failed\n"); return; }
    Args a{};
    for (int i = 0; i < 27; ++i) a.in[i] = (const float*)d_in[i];
    a.out = (float*)d_out; a.ws = (unsigned char*)d_ws;
    hipLaunchKernelGGL(hybrid_fwd, dim3(grid), dim3(NWAVES * 64), LDS_BYTES, stream, a);
    const hipError_t le = hipPeekAtLastError();
    if (le != hipSuccess) fprintf(stderr, "kernel_launch: launch failed: %s\n", hipGetErrorName(le));
}
```

```cpp
#include <hip/hip_runtime.h>
#include <cstdio>
#include <cstdint>

__device__ __forceinline__ int lane_id() { int l; asm volatile("v_mbcnt_lo_u32_b32 %0, -1, 0\n\tv_mbcnt_hi_u32_b32 %0, -1, %0" : "=v"(l)); return l; }

namespace pg8 {
#define PG8_LAS __attribute__((address_space(3)))
typedef unsigned short bf16_t;
typedef short bf16x8 __attribute__((ext_vector_type(8)));
typedef float f32x4 __attribute__((ext_vector_type(4)));
typedef unsigned u32x4 __attribute__((ext_vector_type(4)));
constexpr int BM = 256, BK = 64, HALF = 128, HTB = HALF * BK * 2, STAGE_BYTES = 8 * HTB, NXCD = 8, WGM = 8;

__host__ __device__ __forceinline__ int lds_byte(int r, int c) { const int st = (r >> 4) * 2 + (c >> 5), rr = r & 15, cc = c & 31, ob = rr * 64 + cc * 2; return st * 1024 + (ob ^ (((ob >> 9) & 1) << 5)); }
__host__ __device__ __forceinline__ void stage_rc(int b, int& R, int& C) { const int st = b / 1024, sb = b % 1024, swz = sb ^ (((sb >> 9) & 1) << 5); R = (st >> 1) * 16 + swz / 64; C = (st & 1) * 32 + (swz % 64) / 2; }
__host__ __device__ __forceinline__ int perm32(int rho) { const int n = rho >> 4, i = rho & 15; return 8 * (i >> 2) + 4 * n + (i & 3); }

struct Unit { int pm, pn; };
struct Gemm { const bf16_t* A; const bf16_t* Bt; int M, N, K; };

struct StaticOrder {
    int nM, nN, nwg, G, c;
    __host__ __device__ void init(int M, int N, int G_, int c_) { nM = M / BM; nN = N / BM; nwg = nM * nN; G = G_; c = c_; }
    __host__ __device__ bool next(int i, Unit& u) const {
        const long L = (long)i * G + c; if (L >= nwg) return false;
        int wgid = (int)L; { const int q = nwg / NXCD, r = nwg % NXCD, xcd = wgid % NXCD, off = wgid / NXCD; wgid = (xcd < r ? xcd * (q + 1) : r * (q + 1) + (xcd - r) * q) + off; }
        const int nig = WGM * nN, gid = wgid / nig, fm = gid * WGM, gsz = (nM - fm) < WGM ? (nM - fm) : WGM;
        u.pm = fm + ((wgid % nig) % gsz); u.pn = (wgid % nig) / gsz; return true;
    }
    __device__ __forceinline__ void a_ready(const Unit&) const {}
    __device__ __forceinline__ void done(const Unit&) const {}
};

typedef float f32x2_t __attribute__((ext_vector_type(2))); typedef __bf16 bf16x2_t __attribute__((ext_vector_type(2)));
__device__ __forceinline__ unsigned cvt_pk_bf16(float lo, float hi) { f32x2_t v = {lo, hi}; bf16x2_t b = __builtin_convertvector(v, bf16x2_t); return __builtin_bit_cast(unsigned, b); }

template <class Epi, class Sched, bool ALIGN_EPI = false, bool SP2 = false>
__device__ __forceinline__ void gemm_phase(PG8_LAS unsigned char* lds, const Gemm g, const Sched& S, const Epi& E, int wid) {
    int lane = lane_id(); asm volatile("" : "+v"(lane));
    const int tid = wid * 64 + lane, wr = wid >> 2, wc = wid & 3, fr = lane & 15, fq = lane >> 4;
    const int K = g.K, nt = K / BK;
    unsigned voffA[2], voffB[2];
#pragma unroll
    for (int i = 0; i < 2; ++i) { int R, C; stage_rc(tid * 16 + i * 8192, R, C); const int Rb = Epi::PERM ? ((R & ~31) + perm32(R & 31)) : R;
        voffA[i] = (unsigned)(R * K + C) * 2u; voffB[i] = (unsigned)(Rb * K + C) * 2u; }
    const size_t kstep = (size_t)(BK * 2);
    const size_t hstep = (size_t)HALF * K * 2;
    const size_t tstep = 2 * hstep;
    const unsigned ldsw = (unsigned)wid * 1024u;
    const int aoff = lds_byte(wr * 64 + fr, fq * 8), boff = lds_byte(wc * 32 + fr, fq * 8);
#define PG8_SA(b, h) (((b) * 2 + (h)) * HTB)
#define PG8_SB(b, h) ((4 + (b) * 2 + (h)) * HTB)
#define PG8_STAGE(bufoff, gbase, voff) do { _Pragma("unroll") for (int _i = 0; _i < 2; ++_i) \
        __builtin_amdgcn_global_load_lds((const unsigned*)((const char*)(gbase) + (voff)[_i]), (PG8_LAS unsigned*)(lds + (bufoff) + ldsw + _i * 8192), 16, 0, 0); } while (0)
#define PG8_LDA(dst, b, h) do { _Pragma("unroll") for (int m = 0; m < 4; ++m) _Pragma("unroll") for (int k = 0; k < 2; ++k) dst[m][k] = *(const PG8_LAS bf16x8*)(lds + PG8_SA(b, h) + aoff + m * 2048 + k * 1024); } while (0)
#define PG8_LDB(dst, b, h) do { _Pragma("unroll") for (int n = 0; n < 2; ++n) _Pragma("unroll") for (int k = 0; k < 2; ++k) dst[n][k] = *(const PG8_LAS bf16x8*)(lds + PG8_SB(b, h) + boff + n * 2048 + k * 1024); } while (0)
#define PG8_MMA(ai, bj, At, Bt) do { __builtin_amdgcn_s_setprio(1); _Pragma("unroll") for (int m = 0; m < 4; ++m) _Pragma("unroll") for (int n = 0; n < 2; ++n) _Pragma("unroll") for (int k = 0; k < 2; ++k) \
        acc[ai][bj][m][n] = __builtin_amdgcn_mfma_f32_16x16x32_bf16(Bt[n][k], At[m][k], acc[ai][bj][m][n], 0, 0, 0); __builtin_amdgcn_s_setprio(0); } while (0)
#define PG8_WAIT_V(n) asm volatile("s_waitcnt vmcnt(" #n ")" ::: "memory")
#define PG8_WAIT_L(n) asm volatile("s_waitcnt lgkmcnt(" #n ")" ::: "memory")
#define PG8_BAR __builtin_amdgcn_s_barrier()
#define PG8_SCHED __builtin_amdgcn_sched_barrier(0)
    Unit cur, nxt; int ui = 0;
    if (!S.next(0, cur)) return;
    f32x4 acc[2][2][4][2];
#pragma unroll
    for (int a = 0; a < 2; ++a)
#pragma unroll
        for (int b = 0; b < 2; ++b)
#pragma unroll
            for (int m = 0; m < 4; ++m)
#pragma unroll
                for (int n = 0; n < 2; ++n) acc[a][b][m][n] = (f32x4){0.f, 0.f, 0.f, 0.f};
    bf16x8 At[4][2], B0[2][2], B1[2][2];
    const char* cA = (const char*)g.A + (size_t)cur.pm * tstep; const char* cB = (const char*)g.Bt + (size_t)cur.pn * tstep;
    S.a_ready(cur);
    if constexpr (SP2) {
        PG8_STAGE(PG8_SB(0, 0), cB, voffB); PG8_STAGE(PG8_SB(0, 1), cB + hstep, voffB); PG8_STAGE(PG8_SA(0, 0), cA, voffA); PG8_STAGE(PG8_SA(0, 1), cA + hstep, voffA);
        if (wr == 1) PG8_BAR;
        PG8_WAIT_V(2); PG8_BAR;
        PG8_STAGE(PG8_SB(1, 0), cB + kstep, voffB); PG8_STAGE(PG8_SA(1, 0), cA + kstep, voffA); PG8_STAGE(PG8_SB(1, 1), cB + hstep + kstep, voffB);
        PG8_WAIT_V(6); PG8_BAR;
    } else {
        PG8_STAGE(PG8_SB(0, 0), cB, voffB); PG8_STAGE(PG8_SA(0, 0), cA, voffA); PG8_STAGE(PG8_SB(0, 1), cB + hstep, voffB); PG8_STAGE(PG8_SA(0, 1), cA + hstep, voffA);
        if (wr == 1) PG8_BAR;
        PG8_WAIT_V(4); PG8_BAR;
        PG8_STAGE(PG8_SB(1, 0), cB + kstep, voffB); PG8_STAGE(PG8_SA(1, 0), cA + kstep, voffA); PG8_STAGE(PG8_SB(1, 1), cB + hstep + kstep, voffB);
        PG8_WAIT_V(6); PG8_BAR;
    }
    for (;;) {
        const bool has_next = S.next(ui + 1, nxt);
        const char* nA = has_next ? (const char*)g.A + (size_t)nxt.pm * tstep : cA; const char* nB = has_next ? (const char*)g.Bt + (size_t)nxt.pn * tstep : cB;
        for (int t = 0; t < nt; t += 2) {
            const bool last = (t == nt - 2);
            const char* a1 = cA + (size_t)(t + 1) * kstep;
            const char* a2 = last ? nA : cA + (size_t)(t + 2) * kstep; const char* b2 = last ? nB : cB + (size_t)(t + 2) * kstep;
            const char* a3 = a2 + kstep; const char* b3 = b2 + kstep;
            if (last && has_next) S.a_ready(nxt);
            if constexpr (SP2) {
            PG8_LDB(B0, 0, 0); PG8_LDB(B1, 0, 1); PG8_SCHED; PG8_LDA(At, 0, 0); PG8_STAGE(PG8_SA(1, 1), a1 + hstep, voffA);
            PG8_WAIT_V(8); PG8_WAIT_L(0); PG8_BAR; PG8_MMA(0, 0, At, B0); PG8_MMA(0, 1, At, B1); PG8_BAR; PG8_SCHED;
            PG8_LDA(At, 0, 1); PG8_STAGE(PG8_SB(0, 0), b2, voffB); PG8_STAGE(PG8_SB(0, 1), b2 + hstep, voffB); PG8_STAGE(PG8_SA(0, 0), a2, voffA);
            PG8_WAIT_V(8); PG8_WAIT_L(0); PG8_BAR; PG8_MMA(1, 0, At, B0); PG8_MMA(1, 1, At, B1); PG8_BAR; PG8_SCHED;
            PG8_LDB(B0, 1, 0); PG8_LDB(B1, 1, 1); PG8_SCHED; PG8_LDA(At, 1, 0); PG8_STAGE(PG8_SA(0, 1), a2 + hstep, voffA);
            PG8_WAIT_V(8); PG8_WAIT_L(0); PG8_BAR; PG8_MMA(0, 0, At, B0); PG8_MMA(0, 1, At, B1); PG8_BAR; PG8_SCHED;
            PG8_LDA(At, 1, 1); PG8_STAGE(PG8_SB(1, 0), b3, voffB); PG8_STAGE(PG8_SB(1, 1), b3 + hstep, voffB); PG8_STAGE(PG8_SA(1, 0), a3, voffA);
            PG8_WAIT_V(8); PG8_WAIT_L(0); PG8_BAR; PG8_MMA(1, 0, At, B0); PG8_MMA(1, 1, At, B1); PG8_BAR; PG8_SCHED;
            } else {
            PG8_LDB(B0, 0, 0); PG8_SCHED; PG8_LDA(At, 0, 0); PG8_STAGE(PG8_SA(1, 1), a1 + hstep, voffA);
            PG8_WAIT_L(8); PG8_BAR; PG8_WAIT_L(0); PG8_MMA(0, 0, At, B0); PG8_BAR; PG8_SCHED;
            PG8_LDB(B1, 0, 1); PG8_STAGE(PG8_SB(0, 0), b2, voffB);
            PG8_BAR; PG8_WAIT_L(0); PG8_MMA(0, 1, At, B1); PG8_BAR;
            PG8_LDA(At, 0, 1); PG8_STAGE(PG8_SA(0, 0), a2, voffA);
            PG8_BAR; PG8_WAIT_L(0); PG8_MMA(1, 0, At, B0); PG8_BAR; PG8_SCHED;
            PG8_STAGE(PG8_SB(0, 1), b2 + hstep, voffB);
            PG8_WAIT_V(6); PG8_BAR; PG8_MMA(1, 1, At, B1); PG8_BAR;
            PG8_LDB(B0, 1, 0); PG8_SCHED; PG8_LDA(At, 1, 0); PG8_STAGE(PG8_SA(0, 1), a2 + hstep, voffA);
            PG8_WAIT_L(8); PG8_BAR; PG8_WAIT_L(0); PG8_MMA(0, 0, At, B0); PG8_BAR; PG8_SCHED;
            PG8_LDB(B1, 1, 1); PG8_STAGE(PG8_SB(1, 0), b3, voffB);
            PG8_BAR; PG8_WAIT_L(0); PG8_MMA(0, 1, At, B1); PG8_BAR;
            PG8_LDA(At, 1, 1); PG8_STAGE(PG8_SA(1, 0), a3, voffA);
            PG8_BAR; PG8_WAIT_L(0); PG8_MMA(1, 0, At, B0); PG8_BAR; PG8_SCHED;
            PG8_STAGE(PG8_SB(1, 1), b3 + hstep, voffB);
            PG8_WAIT_V(6); PG8_BAR; PG8_MMA(1, 1, At, B1); PG8_BAR;
            }
        }
        if constexpr (ALIGN_EPI) { if (wr == 0) PG8_BAR; }
        E(acc, cur, wr, wc, fr, fq);
        if (!has_next) break;
#pragma unroll
        for (int a = 0; a < 2; ++a)
#pragma unroll
            for (int b = 0; b < 2; ++b)
#pragma unroll
                for (int m = 0; m < 4; ++m)
#pragma unroll
                    for (int n = 0; n < 2; ++n) acc[a][b][m][n] = (f32x4){0.f, 0.f, 0.f, 0.f};
        cur = nxt; cA = nA; cB = nB; ++ui;
        if constexpr (ALIGN_EPI) { if (wr == 1) PG8_BAR; }
    }
    PG8_WAIT_V(0);
    if constexpr (!ALIGN_EPI) { if (wr == 0) PG8_BAR; }
    PG8_BAR;
#undef PG8_SA
#undef PG8_SB
#undef PG8_STAGE
#undef PG8_LDA
#undef PG8_LDB
#undef PG8_MMA
#undef PG8_WAIT_V
#undef PG8_WAIT_L
#undef PG8_BAR
#undef PG8_SCHED
}
}

constexpr int DM = 4096, NB = 4, SEQ = 2048, MTOK = NB * SEQ;
constexpr int AH = 16, HD = 128, AW = 2048;
constexpr int SW = 2048, SG = 16, NG = 128, SP = 64;
constexpr int DFF = 12288, PLED = 256, INW = 16384;
constexpr float EPS = 1e-6f;
constexpr int NWAVES = 8;

constexpr size_t MiB = 1u << 20;
constexpr size_t WS_CTL = 0, CTL_ZERO_BYTES = 1 * MiB;
constexpr size_t WS_ROPE = 1 * MiB;
constexpr size_t WS_RPLE = 2 * MiB;
constexpr size_t WS_ML = 3 * MiB;
constexpr size_t WS_SSMC = 6 * MiB;
constexpr size_t WS_PB = 8 * MiB;
constexpr size_t WS_WIN = 16 * MiB, WS_WA = 144 * MiB, WS_WB = 160 * MiB, WS_WOUT = 176 * MiB, WS_WGLU = 208 * MiB, WS_WUP = 216 * MiB,
                 WS_WDOWN = 408 * MiB, WS_WPLE = 504 * MiB, WS_WPG = 506 * MiB;
constexpr size_t WS_XN = 540 * MiB;
constexpr size_t WS_PLEB = 604 * MiB;
constexpr size_t WS_OUT1 = 668 * MiB;
constexpr size_t WS_Q = 732 * MiB, WS_K = 764 * MiB, WS_V = 796 * MiB, WS_U = 828 * MiB, WS_GA = 860 * MiB, WS_GB = 924 * MiB;
constexpr size_t WS_PART = 988 * MiB;
constexpr size_t WS_Y0 = 1084 * MiB, WS_Y1 = 1148 * MiB;
constexpr size_t WS_YA = 1212 * MiB, WS_Z = 1244 * MiB, WS_YB = 1276 * MiB;
constexpr size_t WS_TMP = 1308 * MiB;
constexpr size_t WS_H1B = 860 * MiB;
constexpr size_t WS_EA = 732 * MiB, WS_EB = 764 * MiB, WS_ACT = 1116 * MiB;
constexpr size_t WS_END = 1372 * MiB;
constexpr int CW_BAR = 4096, CW_QUEUE = 8192;

constexpr int RING_OFF = 0, RING_BYTES = 131072;
constexpr int SSM_WAVE_BYTES = 32 * 129 * 4;
constexpr int MISC_OFF = 135168;
constexpr int LDS_BYTES = 147456;
static_assert(8 * SSM_WAVE_BYTES <= MISC_OFF && MISC_OFF + 128 <= LDS_BYTES, "LDS map");

#define GAS __attribute__((address_space(1)))
#define LAS __attribute__((address_space(3)))
typedef unsigned short bf16;
typedef unsigned v4u __attribute__((ext_vector_type(4)));
typedef unsigned v2u __attribute__((ext_vector_type(2)));
typedef float f32x4 __attribute__((ext_vector_type(4)));
typedef float f32x16 __attribute__((ext_vector_type(16)));
typedef short bf16x8 __attribute__((ext_vector_type(8)));
typedef short s16x4 __attribute__((ext_vector_type(4)));
#define LDS_WAIT() asm volatile("s_waitcnt lgkmcnt(0)" ::: "memory")
#define VM_WAIT() asm volatile("s_waitcnt vmcnt(0)" ::: "memory")
__device__ __forceinline__ unsigned pk2(float lo, float hi) { return pg8::cvt_pk_bf16(lo, hi); }
__device__ __forceinline__ float bflo(unsigned w) { return __uint_as_float(w << 16); }
__device__ __forceinline__ float bfhi(unsigned w) { return __uint_as_float(w & 0xffff0000u); }
__device__ __forceinline__ float sigm(float x) { return __builtin_amdgcn_rcpf(1.f + __builtin_amdgcn_exp2f(-1.4426950408889634f * x)); }
__device__ __forceinline__ float gelu_tanh(float x) { return x * sigm(1.5957691216057308f * x * (1.f + 0.044715f * x * x)); }
template <int X> __device__ __forceinline__ float swz_xor(float v) { return __int_as_float(__builtin_amdgcn_ds_swizzle(__float_as_int(v), (X << 10) | 0x1f)); }
__device__ __forceinline__ float wave_sum(float v) {
    v += swz_xor<1>(v); v += swz_xor<2>(v); v += swz_xor<4>(v); v += swz_xor<8>(v); v += swz_xor<16>(v);
    auto rr = __builtin_amdgcn_permlane32_swap(__float_as_uint(v), __float_as_uint(v), false, false);
    return __uint_as_float(rr[0]) + __uint_as_float(rr[1]);
}

#define XB_TMO      128
#define XB_XCNT(j)  (256  + 64 * (j))
#define XB_XSUB(j)  (1280 + 64 * (j))
#define XB_XGEN(j)  (2304 + 64 * (j))
#define XB_TOP      3328
#define XB_TOPGEN   3392
#define XCD_BAR_WORDS 3456
#define XB_SPIN_CAP (1u << 18)
__device__ __forceinline__ unsigned xb_ld(unsigned* p)              { return __hip_atomic_load(p, __ATOMIC_RELAXED, __HIP_MEMORY_SCOPE_AGENT); }
__device__ __forceinline__ unsigned xb_add(unsigned* p, unsigned v) { return __hip_atomic_fetch_add(p, v, __ATOMIC_RELAXED, __HIP_MEMORY_SCOPE_AGENT); }
__device__ __forceinline__ unsigned xb_xcc_id() { return (unsigned)__builtin_amdgcn_s_getreg((3 << 11) | 20) & 0xFu; }
#define XB_SPIN(cond, bar) do { unsigned _sp = 0; while (cond) { __builtin_amdgcn_s_sleep(1); \
    if ((++_sp & 255u) == 0u) { if (xb_ld(&(bar)[XB_TMO])) break; if (_sp > XB_SPIN_CAP) { atomicAdd(&(bar)[XB_TMO], 1u); break; } } } } while (0)
struct XcdBarrier { unsigned* bar; unsigned x; volatile LAS unsigned* st; int wave; };
__device__ __forceinline__ XcdBarrier xcd_barrier_post(unsigned* bar, volatile LAS unsigned* st, int wave) {
    XcdBarrier b; b.bar = bar; b.x = xb_xcc_id(); b.st = st; b.wave = wave;
    if (wave == 0 && lane_id() == 0) (void)xb_add(&bar[XB_XCNT(b.x)], 1u);
    return b;
}
__device__ __forceinline__ void xcd_barrier_complete(unsigned* bar, unsigned x, unsigned& nloc, unsigned& nx) {
    const unsigned G = gridDim.x * gridDim.y * gridDim.z;
    unsigned sum, cnt, mine, sp = 0u;
    for (;;) {
        sum = 0u; cnt = 0u; mine = 0u;
#pragma unroll
        for (unsigned j = 0; j < 16; ++j) { const unsigned c = xb_ld(&bar[XB_XCNT(j)]); sum += c; cnt += (c > 0u) ? 1u : 0u; mine = (j == x) ? c : mine; }
        if (sum == G) break;
        __builtin_amdgcn_s_sleep(1);
        if ((++sp & 255u) == 0u) { if (xb_ld(&bar[XB_TMO])) break; if (sp > XB_SPIN_CAP) { atomicAdd(&bar[XB_TMO], 1u); break; } }
    }
    nloc = mine > 0u ? mine : 1u; nx = cnt > 0u ? cnt : 1u;
}
__device__ __forceinline__ void xcd_barrier(const XcdBarrier& b) {
    asm volatile("s_waitcnt vmcnt(0)" ::: "memory");
    __syncthreads();
    if (b.wave == 0 && lane_id() == 0) {
        unsigned* bar = b.bar;
        __builtin_amdgcn_s_waitcnt(0);
        unsigned nloc = b.st[0], nx = b.st[1];
        if (nloc == 0u) { xcd_barrier_complete(bar, b.x, nloc, nx); b.st[0] = nloc; b.st[1] = nx; }
        const unsigned old = xb_add(&bar[XB_XSUB(b.x)], 1u);
        const unsigned gen = old / nloc;
        if (old + 1u == (gen + 1u) * nloc) {
            __builtin_amdgcn_fence(__ATOMIC_RELEASE, "agent");
            asm volatile("s_waitcnt vmcnt(0)" ::: "memory");
            const unsigned og = xb_add(&bar[XB_TOP], 1u);
            const unsigned tg = og / nx;
            if (og + 1u == (tg + 1u) * nx) xb_add(&bar[XB_TOPGEN], 1u);
            else XB_SPIN(xb_ld(&bar[XB_TOPGEN]) == tg, bar);
            __builtin_amdgcn_fence(__ATOMIC_ACQUIRE, "agent");
            xb_add(&bar[XB_XGEN(b.x)], 1u);
            asm volatile("s_waitcnt vmcnt(0)" ::: "memory");
        } else {
            XB_SPIN(xb_ld(&bar[XB_XGEN(b.x)]) == gen, bar);
            __builtin_amdgcn_fence(__ATOMIC_ACQUIRE, "agent");
            asm volatile("s_waitcnt vmcnt(0)" ::: "memory");
        }
    }
    __syncthreads();
}

using pg8::Unit;
struct EpiIn {
    static constexpr bool PERM = true;
    bf16 *Q, *K, *V, *U, *GA, *GB; const float* rope;
    __device__ __forceinline__ void operator()(const f32x4 (&acc)[2][2][4][2], const Unit& u, int wr, int wc, int fr, int fq) const {
        const int row0 = u.pm * 256 + wr * 64 + fr, cl = wc * 32 + 8 * fq;
        if (u.pn < 16) {
            bf16* base = (u.pn < 8 ? Q : K) + (u.pn & 7) * 256 + cl;
#pragma unroll
            for (int ai = 0; ai < 2; ++ai)
#pragma unroll
                for (int m = 0; m < 4; ++m) { const int row = row0 + ai * 128 + m * 16; const float* rp = rope + (size_t)(row & (SEQ - 1)) * 128 + (cl >> 1);
                    const f32x4 cs = *(const f32x4*)rp, sn = *(const f32x4*)(rp + 64);
#pragma unroll
                    for (int bj = 0; bj < 2; ++bj) { const f32x4 x1 = acc[ai][bj][m][0], x2 = acc[ai][bj][m][1];
                        const f32x4 o1 = x1 * cs - x2 * sn, o2 = x2 * cs + x1 * sn;
                        v4u w; w.x = pk2(o1[0], o1[1]); w.y = pk2(o1[2], o1[3]); w.z = pk2(o2[0], o2[1]); w.w = pk2(o2[2], o2[3]);
                        *(v4u*)(base + (size_t)row * AW + bj * 128) = w; } }
        } else if (u.pn < 24) {
            bf16* base = V + (u.pn & 7) * 256 + cl;
#pragma unroll
            for (int ai = 0; ai < 2; ++ai)
#pragma unroll
                for (int m = 0; m < 4; ++m) { const int row = row0 + ai * 128 + m * 16;
#pragma unroll
                    for (int bj = 0; bj < 2; ++bj) { const f32x4 v0 = acc[ai][bj][m][0], v1 = acc[ai][bj][m][1];
                        v4u w; w.x = pk2(v0[0], v0[1]); w.y = pk2(v0[2], v0[3]); w.z = pk2(v1[0], v1[1]); w.w = pk2(v1[2], v1[3]);
                        *(v4u*)(base + (size_t)row * AW + bj * 128) = w; } }
        } else if (u.pn < 32) {
#pragma unroll
            for (int bj = 0; bj < 2; ++bj) { const int col = (u.pn & 7) * 256 + bj * 128 + cl; bf16* base = U + ((size_t)(col >> 4) * MTOK) * SG + (col & 8);
#pragma unroll
                for (int ai = 0; ai < 2; ++ai)
#pragma unroll
                    for (int m = 0; m < 4; ++m) { const int row = row0 + ai * 128 + m * 16; const f32x4 v0 = acc[ai][bj][m][0], v1 = acc[ai][bj][m][1];
                        v4u w; w.x = pk2(v0[0], v0[1]); w.y = pk2(v0[2], v0[3]); w.z = pk2(v1[0], v1[1]); w.w = pk2(v1[2], v1[3]);
                        *(v4u*)(base + (size_t)row * SG) = w; } }
        } else {
            bf16* base = (u.pn < 48 ? GA : GB) + (u.pn & 15) * 256 + cl;
#pragma unroll
            for (int ai = 0; ai < 2; ++ai)
#pragma unroll
                for (int m = 0; m < 4; ++m) { const int row = row0 + ai * 128 + m * 16;
#pragma unroll
                    for (int bj = 0; bj < 2; ++bj) { const f32x4 v0 = acc[ai][bj][m][0], v1 = acc[ai][bj][m][1];
                        v4u w; w.x = pk2(sigm(v0[0]), sigm(v0[1])); w.y = pk2(sigm(v0[2]), sigm(v0[3])); w.z = pk2(sigm(v1[0]), sigm(v1[1])); w.w = pk2(sigm(v1[2]), sigm(v1[3]));
                        *(v4u*)(base + (size_t)row * DM + bj * 128) = w; } }
        }
    }
};
struct EpiPlain {
    static constexpr bool PERM = true;
    bf16* O; int ldc; int split_cols; size_t split_stride;
    __device__ __forceinline__ void operator()(const f32x4 (&acc)[2][2][4][2], const Unit& u, int wr, int wc, int fr, int fq) const {
        const int row0 = u.pm * 256 + wr * 64 + fr; int colt = u.pn * 256; bf16* base = O;
        if (split_cols) { const int t = colt / split_cols; base += (size_t)t * split_stride; colt -= t * split_cols; }
        base += colt + wc * 32 + 8 * fq;
#pragma unroll
        for (int ai = 0; ai < 2; ++ai)
#pragma unroll
            for (int m = 0; m < 4; ++m) { const int row = row0 + ai * 128 + m * 16;
#pragma unroll
                for (int bj = 0; bj < 2; ++bj) { const f32x4 v0 = acc[ai][bj][m][0], v1 = acc[ai][bj][m][1];
                    v4u w; w.x = pk2(v0[0], v0[1]); w.y = pk2(v0[2], v0[3]); w.z = pk2(v1[0], v1[1]); w.w = pk2(v1[2], v1[3]);
                    *(v4u*)(base + (size_t)row * ldc + bj * 128) = w; } }
    }
};
struct EpiGlu {
    static constexpr bool PERM = true;
    const bf16* Z; bf16* YB; const float* bias;
    __device__ __forceinline__ void operator()(const f32x4 (&acc)[2][2][4][2], const Unit& u, int wr, int wc, int fr, int fq) const {
        const int row0 = u.pm * 256 + wr * 64 + fr, col0 = u.pn * 256 + wc * 32 + 8 * fq;
#pragma unroll
        for (int bj = 0; bj < 2; ++bj) { const f32x4 b0 = *(const f32x4*)(bias + col0 + bj * 128), b1 = *(const f32x4*)(bias + col0 + bj * 128 + 4);
#pragma unroll
            for (int ai = 0; ai < 2; ++ai)
#pragma unroll
                for (int m = 0; m < 4; ++m) { const size_t off = (size_t)(row0 + ai * 128 + m * 16) * SW + col0 + bj * 128;
                    const v4u z = *(const v4u*)(Z + off); const f32x4 v0 = acc[ai][bj][m][0] + b0, v1 = acc[ai][bj][m][1] + b1;
                    v4u w; w.x = pk2(bflo(z.x) * sigm(v0[0]), bfhi(z.x) * sigm(v0[1])); w.y = pk2(bflo(z.y) * sigm(v0[2]), bfhi(z.y) * sigm(v0[3]));
                    w.z = pk2(bflo(z.z) * sigm(v1[0]), bfhi(z.z) * sigm(v1[1])); w.w = pk2(bflo(z.w) * sigm(v1[2]), bfhi(z.w) * sigm(v1[3]));
                    *(v4u*)(YB + off) = w; } }
    }
};
template <bool FIRST> struct EpiGate {
    static constexpr bool PERM = true;
    const bf16* G; bf16* T;
    __device__ __forceinline__ void operator()(const f32x4 (&acc)[2][2][4][2], const Unit& u, int wr, int wc, int fr, int fq) const {
        const int row0 = u.pm * 256 + wr * 64 + fr, col0 = u.pn * 256 + wc * 32 + 8 * fq;
#pragma unroll
        for (int ai = 0; ai < 2; ++ai)
#pragma unroll
            for (int m = 0; m < 4; ++m)
#pragma unroll
                for (int bj = 0; bj < 2; ++bj) { const size_t off = (size_t)(row0 + ai * 128 + m * 16) * DM + col0 + bj * 128;
                    const v4u g = *(const v4u*)(G + off); const f32x4 v0 = acc[ai][bj][m][0], v1 = acc[ai][bj][m][1];
                    float o[8] = { bflo(g.x) * v0[0], bfhi(g.x) * v0[1], bflo(g.y) * v0[2], bfhi(g.y) * v0[3], bflo(g.z) * v1[0], bfhi(g.z) * v1[1], bflo(g.w) * v1[2], bfhi(g.w) * v1[3] };
                    if (!FIRST) { const v4u t = *(const v4u*)(T + off);
                        o[0] += bflo(t.x); o[1] += bfhi(t.x); o[2] += bflo(t.y); o[3] += bfhi(t.y); o[4] += bflo(t.z); o[5] += bfhi(t.z); o[6] += bflo(t.w); o[7] += bfhi(t.w); }
                    v4u w; w.x = pk2(o[0], o[1]); w.y = pk2(o[2], o[3]); w.z = pk2(o[4], o[5]); w.w = pk2(o[6], o[7]);
                    *(v4u*)(T + off) = w; }
    }
};
template <int CTRL> __device__ __forceinline__ float dppf(float v) { return __int_as_float(__builtin_amdgcn_update_dpp(0, __float_as_int(v), CTRL, 0xf, 0xf, true)); }
struct EpiUp {
    static constexpr bool PERM = true;
    bf16* ACT; float* EA; float* EB; const float* cw; const float* cb;
    __device__ __forceinline__ void operator()(const f32x4 (&acc)[2][2][4][2], const Unit& u, int wr, int wc, int fr, int fq) const {
        const int ch0 = u.pn * 128 + wc * 32 + 8 * fq;
        f32x4 w0[2], w1[2], w2[2], bs[2];
#pragma unroll
        for (int n = 0; n < 2; ++n) { w0[n] = *(const f32x4*)(cw + ch0 + 4 * n); w1[n] = *(const f32x4*)(cw + DFF + ch0 + 4 * n); w2[n] = *(const f32x4*)(cw + 2 * DFF + ch0 + 4 * n); bs[n] = *(const f32x4*)(cb + ch0 + 4 * n); }
        const f32x4 zero4 = (f32x4){0.f, 0.f, 0.f, 0.f};
#pragma unroll
        for (int ai = 0; ai < 2; ++ai) {
            const int blk = u.pm * 4 + 2 * ai + wr; const int rowb = blk * 64;
#pragma unroll
            for (int m = 0; m < 4; ++m) {
                unsigned ow[4];
#pragma unroll
                for (int n = 0; n < 2; ++n) {
                    const f32x4 cur = acc[ai][0][m][n], up = m > 0 ? acc[ai][0][m - 1][n] : zero4, dn = m < 3 ? acc[ai][0][m + 1][n] : zero4, bv = acc[ai][1][m][n];
                    float o[4];
#pragma unroll
                    for (int e = 0; e < 4; ++e) {
                        const float p_in = dppf<0x111>(cur[e]), p_ed = dppf<0x121>(up[e]);
                        const float n_in = dppf<0x101>(cur[e]), n_ed = dppf<0x12F>(dn[e]);
                        const float prev = fr == 0 ? p_ed : p_in, next = fr == 15 ? n_ed : n_in;
                        o[e] = gelu_tanh(bs[n][e] + w0[n][e] * prev + w1[n][e] * cur[e] + w2[n][e] * next) * bv[e]; }
                    ow[2 * n] = pk2(o[0], o[1]); ow[2 * n + 1] = pk2(o[2], o[3]);
                }
                const bool first = (m == 0 && fr == 0), last = (m == 3 && fr == 15);
                if (!(first || last)) *(v4u*)(ACT + (size_t)(rowb + 16 * m + fr) * DFF + ch0) = (v4u){ow[0], ow[1], ow[2], ow[3]};
                if (m == 0 && fr < 2) { float* ea = EA + ((size_t)blk * 4 + fr) * DFF + ch0; *(f32x4*)ea = acc[ai][0][0][0]; *(f32x4*)(ea + 4) = acc[ai][0][0][1];
                    if (fr == 0) { float* eb = EB + ((size_t)blk * 2) * DFF + ch0; *(f32x4*)eb = acc[ai][1][0][0]; *(f32x4*)(eb + 4) = acc[ai][1][0][1]; } }
                if (m == 3 && fr >= 14) { float* ea = EA + ((size_t)blk * 4 + (fr - 12)) * DFF + ch0; *(f32x4*)ea = acc[ai][0][3][0]; *(f32x4*)(ea + 4) = acc[ai][0][3][1];
                    if (fr == 15) { float* eb = EB + ((size_t)blk * 2 + 1) * DFF + ch0; *(f32x4*)eb = acc[ai][1][3][0]; *(f32x4*)(eb + 4) = acc[ai][1][3][1]; } }
            }
        }
    }
};
struct EpiFinal {
    static constexpr bool PERM = true;
    float* out; const bf16* H2; const bf16* PLEB; const float* rple; const float* gple;
    __device__ __forceinline__ void operator()(const f32x4 (&acc)[2][2][4][2], const Unit& u, int wr, int wc, int fr, int fq) const {
        const int row0 = u.pm * 256 + wr * 64 + fr, col0 = u.pn * 256 + wc * 32 + 8 * fq;
#pragma unroll
        for (int bj = 0; bj < 2; ++bj) { const f32x4 g0 = *(const f32x4*)(gple + col0 + bj * 128), g1 = *(const f32x4*)(gple + col0 + bj * 128 + 4);
#pragma unroll
            for (int ai = 0; ai < 2; ++ai)
#pragma unroll
                for (int m = 0; m < 4; ++m) { const int row = row0 + ai * 128 + m * 16; const size_t off = (size_t)row * DM + col0 + bj * 128;
                    const float rs = rple[row]; const v4u pw = *(const v4u*)(PLEB + off);
                    const v4u hw = *(const v4u*)(H2 + off); const f32x4 h0 = (f32x4){bflo(hw.x), bfhi(hw.x), bflo(hw.y), bfhi(hw.y)}, h1 = (f32x4){bflo(hw.z), bfhi(hw.z), bflo(hw.w), bfhi(hw.w)}; const f32x4 v0 = acc[ai][bj][m][0], v1 = acc[ai][bj][m][1];
                    f32x4 o0, o1;
                    o0[0] = h0[0] + sigm(v0[0]) * (bflo(pw.x) * rs * g0[0]); o0[1] = h0[1] + sigm(v0[1]) * (bfhi(pw.x) * rs * g0[1]);
                    o0[2] = h0[2] + sigm(v0[2]) * (bflo(pw.y) * rs * g0[2]); o0[3] = h0[3] + sigm(v0[3]) * (bfhi(pw.y) * rs * g0[3]);
                    o1[0] = h1[0] + sigm(v1[0]) * (bflo(pw.z) * rs * g1[0]); o1[1] = h1[1] + sigm(v1[1]) * (bfhi(pw.z) * rs * g1[1]);
                    o1[2] = h1[2] + sigm(v1[2]) * (bflo(pw.w) * rs * g1[2]); o1[3] = h1[3] + sigm(v1[3]) * (bfhi(pw.w) * rs * g1[3]);
                    *(f32x4*)(out + off) = o0; *(f32x4*)(out + off + 4) = o1; } }
    }
};

__device__ __forceinline__ int qk_perm(int n) {
    const int i = n & 127, b = n & ~127;
    return i < 64 ? b + 8 * (i >> 2) + (i & 3) : b + 8 * ((i - 64) >> 2) + 4 + (i & 3);
}
struct TRef { const float* W; bf16* WT; int K, N, item, up; };
__device__ __forceinline__ void titem_load(const TRef& t, float (&v)[32], int lane) {
    const int nblk = t.N >> 5, kb = t.item / nblk, nb = t.item - kb * nblk, k0 = kb << 6, n0 = nb << 5;
    const float* src = t.W + (size_t)(k0 + (lane >> 5)) * t.N + n0 + (lane & 31);
#pragma unroll
    for (int i = 0; i < 32; ++i) v[i] = src[(size_t)(2 * i) * t.N];
}
template <int MODE>
__device__ __forceinline__ void titem_store(const TRef& t, const float (&v)[32], LAS float* scr, int lane) {
    const int nblk = t.N >> 5, kb = t.item / nblk, nb = t.item - kb * nblk, k0 = kb << 6, n0 = nb << 5;
    unsigned d[16];
#pragma unroll
    for (int i = 0; i < 16; ++i) { auto r = __builtin_amdgcn_permlane32_swap(__float_as_uint(v[i]), __float_as_uint(v[i + 16]), false, false);
        d[i] = pk2(__uint_as_float(r[0]), __uint_as_float(r[1])); }
    LAS char* sb = (LAS char*)scr;
    LAS v4u* wp = (LAS v4u*)(sb + (lane & 31) * 144 + (lane >> 5) * 64);
#pragma unroll
    for (int q = 0; q < 4; ++q) wp[q] = (v4u){d[4 * q], d[4 * q + 1], d[4 * q + 2], d[4 * q + 3]};
    LDS_WAIT(); asm volatile("" ::: "memory");
    const int c = lane & 7;
#pragma unroll
    for (int j = 0; j < 4; ++j) { const int n = (lane >> 3) + 8 * j; const v4u o = *(const LAS v4u*)(sb + n * 144 + c * 16);
        int dn = n0 + n; if (MODE == 1) dn = (dn < 4096) ? qk_perm(dn) : dn;
        if (MODE == 2) { const int cch = dn < DFF ? dn : dn - DFF; dn = ((cch >> 7) << 8) + (dn < DFF ? 0 : 128) + (cch & 127); }
        *(v4u*)(t.WT + (size_t)dn * t.K + k0 + 8 * c) = o; }
    LDS_WAIT(); asm volatile("" ::: "memory");
}
template <int MODE>
__device__ __forceinline__ void transpose_item(const float* __restrict__ W, int K, int N, bf16* __restrict__ WT, LAS float* scr, int item, int lane) {
    TRef t; t.W = W; t.WT = WT; t.K = K; t.N = N; t.item = item; t.up = 0; float v[32]; titem_load(t, v, lane); titem_store<MODE>(t, v, scr, lane);
}
__device__ __forceinline__ void sincos_rev(double frac, double& s, double& c) {
    const double q = __builtin_rint(frac * 4.0); const double r = (frac - q * 0.25) * 6.283185307179586476925; const double r2 = r * r;
    double sp = -1.0 / 6227020800.0; sp = sp * r2 + 1.0 / 39916800.0; sp = sp * r2 - 1.0 / 362880.0; sp = sp * r2 + 1.0 / 5040.0; sp = sp * r2 - 1.0 / 120.0; sp = sp * r2 + 1.0 / 6.0; sp = r - r * r2 * sp;
    double cp = 1.0 / 479001600.0; cp = cp * r2 - 1.0 / 3628800.0; cp = cp * r2 + 1.0 / 40320.0; cp = cp * r2 - 1.0 / 720.0; cp = cp * r2 + 1.0 / 24.0; cp = cp * r2 - 0.5; cp = 1.0 + r2 * cp;
    const int qi = ((int)q) & 3;
    s = (qi == 0) ? sp : (qi == 1) ? cp : (qi == 2) ? -sp : -cp;
    c = (qi == 0) ? cp : (qi == 1) ? -sp : (qi == 2) ? -cp : sp;
}
__device__ __forceinline__ void sincos_rad(double ang, double& s, double& c) { const double rev = ang * 0.15915494309189533577; sincos_rev(rev - __builtin_rint(rev), s, c); }
__device__ __forceinline__ double exp_small(double x) {
    double p = 1.0 / 362880.0; p = p * x + 1.0 / 40320.0; p = p * x + 1.0 / 5040.0; p = p * x + 1.0 / 720.0; p = p * x + 1.0 / 120.0; p = p * x + 1.0 / 24.0; p = p * x + 1.0 / 6.0; p = p * x + 0.5; p = p * x + 1.0; return p * x + 1.0;
}
typedef __amdgpu_buffer_rsrc_t rsrc_t;
__device__ __forceinline__ rsrc_t mk_rsrc(const void* p, int bytes) { return __builtin_amdgcn_make_buffer_rsrc((void*)p, (short)0, bytes, 0x00020000); }
__device__ __forceinline__ f32x4 bl16(rsrc_t r, int voff, int soff) { return __builtin_bit_cast(f32x4, __builtin_amdgcn_raw_buffer_load_b128(r, voff, soff, 0)); }
__device__ __forceinline__ v2u bl8(rsrc_t r, int voff, int soff) { return __builtin_bit_cast(v2u, __builtin_amdgcn_raw_buffer_load_b64(r, voff, soff, 0)); }
__device__ __forceinline__ void bs16(f32x4 v, rsrc_t r, int voff, int soff) { __builtin_amdgcn_raw_buffer_store_b128(__builtin_bit_cast(v4u, v), r, voff, soff, 0); }
__device__ __forceinline__ void bs8(v2u v, rsrc_t r, int voff, int soff) { __builtin_amdgcn_raw_buffer_store_b64(v, r, voff, soff, 0); }
__device__ __forceinline__ void rms_row_to_bf16(const float* xrow, const float* gain, bf16* orow, int lane) {
    const int o16 = lane * 16, o8 = lane * 8;
    const rsrc_t rx = mk_rsrc(xrow, DM * 4), rg = mk_rsrc(gain, DM * 4), ro = mk_rsrc(orow, DM * 2);
    f32x4 v[16]; float ss = 0.f;
#pragma unroll
    for (int j = 0; j < 16; ++j) { v[j] = bl16(rx, o16, 1024 * j); ss += (v[j].x * v[j].x + v[j].y * v[j].y) + (v[j].z * v[j].z + v[j].w * v[j].w); }
    const float rstd = 1.f / sqrtf(wave_sum(ss) * (1.f / DM) + EPS);
#pragma unroll
    for (int j = 0; j < 16; ++j) { const f32x4 g = bl16(rg, o16, 1024 * j); v2u w; w.x = pk2(v[j].x * rstd * g.x, v[j].y * rstd * g.y); w.y = pk2(v[j].z * rstd * g.z, v[j].w * rstd * g.w); bs8(w, ro, o8, 512 * j); }
}

namespace att {
constexpr float SCALE = 0.088388347648318440f, CEXP = SCALE * 1.4426950408889634f;
#define KSWZ(row, colB) ((row) * 256 + ((colB) ^ (((row) & 7) << 4)))
__device__ __forceinline__ int crow(int r, int hi) { return (r & 3) + 8 * (r >> 2) + 4 * hi; }
__device__ __forceinline__ int v_st(int k, int c) { const int kk = (k & ~0xC) | ((k & 4) << 1) | ((k & 8) >> 1); return ((kk >> 3) * 4 + (c >> 5)) * 512 + ((kk & 7) * 32 + (c & 31)) * 2; }
__device__ __forceinline__ int v_rd_base(int lane) { return ((lane & 3) << 3) | (((lane >> 2) & 3) << 6) | (((lane >> 4) & 1) << 5) | (((lane >> 5) & 1) << 8); }
constexpr int v_rd_off(int d0, int ks, int half) { return d0 * 512 + ks * 4096 + half * 2048; }
template <int OFF> __device__ __forceinline__ s16x4 tr_read(int vb) {
    s16x4 r; asm volatile("ds_read_b64_tr_b16 %0, %1 offset:%2" : "=&v"(r) : "v"(vb), "i"(OFF) : "memory"); return r;
}
template <int D0> __device__ __forceinline__ void pv_one(f32x16& od, int vb, bf16x8 pa0, bf16x8 pa1, bf16x8 pa2, bf16x8 pa3) {
    const s16x4 l0 = tr_read<v_rd_off(D0, 0, 0)>(vb), h0 = tr_read<v_rd_off(D0, 0, 1)>(vb), l1 = tr_read<v_rd_off(D0, 1, 0)>(vb), h1 = tr_read<v_rd_off(D0, 1, 1)>(vb);
    const s16x4 l2 = tr_read<v_rd_off(D0, 2, 0)>(vb), h2 = tr_read<v_rd_off(D0, 2, 1)>(vb), l3 = tr_read<v_rd_off(D0, 3, 0)>(vb), h3 = tr_read<v_rd_off(D0, 3, 1)>(vb);
    asm volatile("s_waitcnt lgkmcnt(0)" ::: "memory"); __builtin_amdgcn_sched_barrier(0);
#define PK(L, H) (bf16x8){L[0], L[1], L[2], L[3], H[0], H[1], H[2], H[3]}
    od = __builtin_amdgcn_mfma_f32_32x32x16_bf16(pa0, PK(l0, h0), od, 0, 0, 0);
    od = __builtin_amdgcn_mfma_f32_32x32x16_bf16(pa1, PK(l1, h1), od, 0, 0, 0);
    od = __builtin_amdgcn_mfma_f32_32x32x16_bf16(pa2, PK(l2, h2), od, 0, 0, 0);
    od = __builtin_amdgcn_mfma_f32_32x32x16_bf16(pa3, PK(l3, h3), od, 0, 0, 0);
#undef PK
}
__device__ __forceinline__ void attn_unit(int uid, const bf16* __restrict__ Qg, const bf16* __restrict__ Kg, const bf16* __restrict__ Vg, bf16* __restrict__ PART, float* __restrict__ ML, LAS char* lds, int wid) {
    int lane = lane_id(); asm volatile("" : "+v"(lane));
    const int tid = wid * 64 + lane, r32 = lane & 31, hi = lane >> 5;
    const int pidx = uid >> 9, rem = uid & 511, bh = rem >> 3, sub = rem & 7, b = bh >> 4, h = bh & 15;
    const int dsh = 2 * pidx, d = 1 << dsh;
    int my_res, sub0, nt, tk0, tres0;
    if (pidx == 0)      { my_res = 0; sub0 = 256 * sub + 32 * wid; tres0 = 0; const int lo = 4 * sub - 1, hi_t = 4 * sub + 4; tk0 = lo < 0 ? 0 : lo; nt = (hi_t > 31 ? 31 : hi_t) - tk0 + 1; }
    else if (pidx == 1) { my_res = sub >> 1; const int blk = sub & 1; sub0 = 256 * blk + 32 * wid; tres0 = my_res; const int lo = 4 * blk - 1, hi_t = 4 * blk + 4; tk0 = lo < 0 ? 0 : lo; nt = (hi_t > 7 ? 7 : hi_t) - tk0 + 1; }
    else                { my_res = 2 * sub + (wid >> 2); sub0 = 32 * (wid & 3); tres0 = 2 * sub; tk0 = 0; nt = 4; }
    LAS char* K_lds = lds; LAS char* V_lds = lds + 16384; LAS float* al_l = (LAS float*)(lds + 32768) + wid * 64; LAS float* li_l = al_l + 32;
    const size_t tokb = (size_t)b * SEQ;
    bf16x8 qr[8];
    { const bf16* qp = Qg + (tokb + my_res + ((size_t)(sub0 + r32) << dsh)) * AW + h * HD + hi * 8;
#pragma unroll
      for (int d0 = 0; d0 < 8; ++d0) qr[d0] = *(const bf16x8*)(qp + d0 * 16); }
    float m_reg = -1e30f, l_reg = 0.f; f32x16 o[4];
#pragma unroll
    for (int d0 = 0; d0 < 4; ++d0) o[d0] = (f32x16){0.f, 0.f, 0.f, 0.f, 0.f, 0.f, 0.f, 0.f, 0.f, 0.f, 0.f, 0.f, 0.f, 0.f, 0.f, 0.f};
    const int sr = tid >> 4, sc = (tid & 15) * 8, vst0 = v_st(sr, sc), vst1 = v_st(32 + sr, sc);
    const int vb0 = (int)(unsigned)(uintptr_t)V_lds + v_rd_base(lane);
    bf16x8 gk0, gk1, gv0, gv1;
#define ATT_GLOAD(T) do { int tres_, ttk_; if (pidx == 2) { tres_ = tres0 + ((T) >> 1); ttk_ = (T) & 1; } else { tres_ = tres0; ttk_ = tk0 + (T); } \
        const size_t tok0 = tokb + tres_ + ((size_t)(64 * ttk_ + sr) << dsh), tok1 = tok0 + ((size_t)32 << dsh); \
        gk0 = *(const bf16x8*)(Kg + tok0 * AW + h * HD + sc); gk1 = *(const bf16x8*)(Kg + tok1 * AW + h * HD + sc); \
        gv0 = *(const bf16x8*)(Vg + tok0 * AW + h * HD + sc); gv1 = *(const bf16x8*)(Vg + tok1 * AW + h * HD + sc); } while (0)
    ATT_GLOAD(0);
    for (int t = 0; t < nt; ++t) {
        int tres, ttk; if (pidx == 2) { tres = tres0 + (t >> 1); ttk = t & 1; } else { tres = tres0; ttk = tk0 + t; }
        __syncthreads();
        *(LAS bf16x8*)(K_lds + KSWZ(sr, sc * 2)) = gk0; *(LAS bf16x8*)(K_lds + KSWZ(32 + sr, sc * 2)) = gk1;
        *(LAS bf16x8*)(V_lds + vst0) = gv0; *(LAS bf16x8*)(V_lds + vst1) = gv1;
        if (t + 1 < nt) ATT_GLOAD(t + 1);
        __syncthreads();
        const bool need = (tres == my_res) && (64 * ttk + 63 >= sub0 - 64) && (64 * ttk <= sub0 + 95);
        if (need) {
            f32x16 p0 = (f32x16){0.f, 0.f, 0.f, 0.f, 0.f, 0.f, 0.f, 0.f, 0.f, 0.f, 0.f, 0.f, 0.f, 0.f, 0.f, 0.f}, p1 = p0;
#pragma unroll
            for (int d0 = 0; d0 < 8; ++d0) { const int cb = (d0 * 16 + hi * 8) * 2;
                const bf16x8 b0 = *(const LAS bf16x8*)(K_lds + KSWZ(r32, cb)), b1 = *(const LAS bf16x8*)(K_lds + KSWZ(32 + r32, cb));
                p0 = __builtin_amdgcn_mfma_f32_32x32x16_bf16(b0, qr[d0], p0, 0, 0, 0);
                p1 = __builtin_amdgcn_mfma_f32_32x32x16_bf16(b1, qr[d0], p1, 0, 0, 0); }
            const int dk = 64 * ttk - (sub0 + r32);
            float pmax = -INFINITY;
#pragma unroll
            for (int r = 0; r < 16; ++r) { const int e0 = dk + crow(r, hi), e1 = e0 + 32;
                p0[r] = (e0 >= -64 && e0 <= 64) ? p0[r] : -INFINITY; p1[r] = (e1 >= -64 && e1 <= 64) ? p1[r] : -INFINITY;
                pmax = fmaxf(pmax, fmaxf(p0[r], p1[r])); }
            { auto rr = __builtin_amdgcn_permlane32_swap(__float_as_uint(pmax), __float_as_uint(pmax), false, false); pmax = fmaxf(__uint_as_float(rr[0]), __uint_as_float(rr[1])); }
            const float mn = fmaxf(m_reg, pmax), alpha = __builtin_amdgcn_exp2f((m_reg - mn) * CEXP); m_reg = mn;
            const float mnC = -mn * CEXP; float ps = 0.f;
#pragma unroll
            for (int r = 0; r < 16; ++r) { p0[r] = __builtin_amdgcn_exp2f(fmaf(p0[r], CEXP, mnC)); p1[r] = __builtin_amdgcn_exp2f(fmaf(p1[r], CEXP, mnC)); ps += p0[r] + p1[r]; }
            { auto rr = __builtin_amdgcn_permlane32_swap(__float_as_uint(ps), __float_as_uint(ps), false, false); ps = __uint_as_float(rr[0]) + __uint_as_float(rr[1]); }
            l_reg = l_reg * alpha + ps;
            if (hi == 0) al_l[r32] = alpha;
            asm volatile("s_waitcnt lgkmcnt(0)" ::: "memory");
#pragma unroll
            for (int r = 0; r < 16; ++r) { const float a = al_l[crow(r, hi)];
#pragma unroll
                for (int d0 = 0; d0 < 4; ++d0) o[d0][r] *= a; }
            bf16x8 pa0, pa1, pa2, pa3;
#define PK4(P, BASE, OUT) do { unsigned a0 = pk2(P[BASE + 0], P[BASE + 1]), a1 = pk2(P[BASE + 2], P[BASE + 3]);   \
    unsigned b0 = pk2(P[BASE + 4], P[BASE + 5]), b1 = pk2(P[BASE + 6], P[BASE + 7]);                              \
    auto r0 = __builtin_amdgcn_permlane32_swap(a0, b0, false, false); auto r1 = __builtin_amdgcn_permlane32_swap(a1, b1, false, false); \
    v4u w = {r0[0], r1[0], r0[1], r1[1]}; OUT = *reinterpret_cast<bf16x8*>(&w); } while (0)
            PK4(p0, 0, pa0); PK4(p0, 8, pa1); PK4(p1, 0, pa2); PK4(p1, 8, pa3);
#undef PK4
            pv_one<0>(o[0], vb0, pa0, pa1, pa2, pa3); pv_one<1>(o[1], vb0, pa0, pa1, pa2, pa3); pv_one<2>(o[2], vb0, pa0, pa1, pa2, pa3); pv_one<3>(o[3], vb0, pa0, pa1, pa2, pa3);
        }
    }
#undef ATT_GLOAD
    if (hi == 0) { li_l[r32] = l_reg; const size_t tq = tokb + my_res + ((size_t)(sub0 + r32) << dsh);
        float* mlp = ML + (((size_t)pidx * MTOK + tq) * AH + h) * 2; mlp[0] = m_reg; mlp[1] = l_reg; }
    asm volatile("s_waitcnt lgkmcnt(0)" ::: "memory");
    bf16* Pp = PART + (size_t)pidx * MTOK * AW + h * HD + r32;
#pragma unroll
    for (int r = 0; r < 16; ++r) { const int qi = crow(r, hi); const float rl = __builtin_amdgcn_rcpf(li_l[qi]);
        const size_t tq = tokb + my_res + ((size_t)(sub0 + qi) << dsh);
#pragma unroll
        for (int d0 = 0; d0 < 4; ++d0) Pp[tq * AW + d0 * 32] = (bf16)(pk2(o[d0][r] * rl, 0.f) & 0xffffu); }
    __syncthreads();
}
}

__device__ __forceinline__ void ssm_group(int g, const float* const* in, const float* __restrict__ ssmc, const bf16* __restrict__ U, float* __restrict__ Y0, float* __restrict__ Y1, bf16* __restrict__ Z, LAS char* lds, int wid) {
    int lane = lane_id(); asm volatile("" : "+v"(lane));
    const int n = lane & 31, hh = lane >> 5;
    const int dir = wid >> 2, b = wid & 3, dg = dir * NG + g;
        const float* b_re = in[11]; const float* b_im = in[12]; const float* c_re = in[13]; const float* c_im = in[14];
    LAS char* wl = lds + wid * SSM_WAVE_BYTES;
    LAS float* tab = (LAS float*)(wl + 4096);
    LAS v4u* bfl = (LAS v4u*)wl;
    {
        const f32x4 c0 = *(const f32x4*)(ssmc + ((size_t)dg * SP + lane) * 8); const f32x4 c1 = *(const f32x4*)(ssmc + ((size_t)dg * SP + lane) * 8 + 4);
        tab[lane] = c0[0]; tab[64 + lane] = c0[1]; tab[128 + lane] = c0[2]; tab[192 + lane] = c0[3]; tab[256 + lane] = c1[0]; tab[320 + lane] = c1[1];
    }
    LDS_WAIT();
    {
#pragma unroll
        for (int t = 0; t < 2; ++t) { const int ps = 32 * t + n; const float fr = tab[256 + ps], fi = tab[320 + ps];
            const f32x4* br = (const f32x4*)(b_re + ((size_t)dg * SP + ps) * SG + 8 * hh); const f32x4* bi = (const f32x4*)(b_im + ((size_t)dg * SP + ps) * SG + 8 * hh);
            const f32x4 r0 = br[0], r1 = br[1], i0 = bi[0], i1 = bi[1];
            const f32x4 re0 = fr * r0 - fi * i0, re1 = fr * r1 - fi * i1, im0 = fr * i0 + fi * r0, im1 = fr * i1 + fi * r1;
            v4u wr_; wr_.x = pk2(re0[0], re0[1]); wr_.y = pk2(re0[2], re0[3]); wr_.z = pk2(re1[0], re1[1]); wr_.w = pk2(re1[2], re1[3]);
            v4u wi_; wi_.x = pk2(im0[0], im0[1]); wi_.y = pk2(im0[2], im0[3]); wi_.z = pk2(im1[0], im1[1]); wi_.w = pk2(im1[2], im1[3]);
            bfl[t * 64 + lane] = wr_; bfl[(2 + t) * 64 + lane] = wi_; }
    }
    float ar0[16], ai0[16], ar1[16], ai1[16];
#pragma unroll
    for (int i = 0; i < 16; ++i) { const int p = att::crow(i, hh); ar0[i] = tab[p]; ai0[i] = tab[64 + p]; ar1[i] = tab[32 + p]; ai1[i] = tab[96 + p]; }
    const float aTr = tab[128 + lane], aTi = tab[192 + lane];
    LDS_WAIT();
    const bf16* ub = U + ((size_t)g * MTOK + (size_t)b * SEQ) * SG + 8 * hh;
    const long ustep = dir ? -(long)SG : (long)SG;
    const bf16* up0 = ub + (size_t)(dir ? (SEQ - 1 - 64 * n) : 64 * n) * SG;
    const f32x16 zero16 = (f32x16){0.f, 0.f, 0.f, 0.f, 0.f, 0.f, 0.f, 0.f, 0.f, 0.f, 0.f, 0.f, 0.f, 0.f, 0.f, 0.f};
    f32x16 H0 = zero16, H1 = zero16, H2 = zero16, H3 = zero16;
#define SSM_HALF(Ha, Hb, ar_, ai_, Bfa, Bfb, uvec) do { f32x16 Ra, Rb; \
    _Pragma("unroll") for (int i = 0; i < 16; ++i) { Ra[i] = ar_[i] * Ha[i] - ai_[i] * Hb[i]; Rb[i] = ar_[i] * Hb[i] + ai_[i] * Ha[i]; } \
    Ha = __builtin_amdgcn_mfma_f32_32x32x16_bf16(Bfa, uvec, Ra, 0, 0, 0); Hb = __builtin_amdgcn_mfma_f32_32x32x16_bf16(Bfb, uvec, Rb, 0, 0, 0); } while (0)
#define SSM_BF(t) (*(const LAS bf16x8*)(wl + ((t) * 64 + lane) * 16))
#define SSM_STEP(uvec) do { SSM_HALF(H0, H2, ar0, ai0, SSM_BF(0), SSM_BF(2), uvec); __builtin_amdgcn_sched_barrier(0); SSM_HALF(H1, H3, ar1, ai1, SSM_BF(1), SSM_BF(3), uvec); __builtin_amdgcn_sched_barrier(0); } while (0)
    {
        const bf16* up = up0;
        bf16x8 ua0 = *(const bf16x8*)up, ua1 = *(const bf16x8*)(up + ustep);
#pragma unroll 1
        for (int s = 0; s < 64; s += 2) {
            const bf16x8 n0 = *(const bf16x8*)(up + ((s + 2) & 63) * ustep), n1 = *(const bf16x8*)(up + ((s + 3) & 63) * ustep);
            SSM_STEP(ua0); SSM_STEP(ua1);
            ua0 = n0; ua1 = n1;
        }
    }
#define SSM_SCAN(Ha, Hb, FIRST) do { \
    _Pragma("unroll") for (int i = 0; i < 16; ++i) { const int r = att::crow(i, hh); tab[n * 65 + r] = Ha[i]; tab[n * 65 + 32 + r] = Hb[i]; } \
    LDS_WAIT(); \
    if ((lane < 32) == (FIRST)) { const int col = lane & 31; float cr = 0.f, ci = 0.f; \
        for (int k = 0; k < 32; ++k) { const float sr = tab[k * 65 + col], si = tab[k * 65 + 32 + col]; \
            tab[k * 65 + col] = cr; tab[k * 65 + 32 + col] = ci; \
            const float nr = aTr * cr - aTi * ci + sr, ni = aTr * ci + aTi * cr + si; cr = nr; ci = ni; } } \
    LDS_WAIT(); \
    _Pragma("unroll") for (int i = 0; i < 16; ++i) { const int r = att::crow(i, hh); Ha[i] = tab[n * 65 + r]; Hb[i] = tab[n * 65 + 32 + r]; } \
    LDS_WAIT(); } while (0)
    SSM_SCAN(H0, H2, true);
    SSM_SCAN(H1, H3, false);
#undef SSM_SCAN
    {
        LAS v4u* ctab = (LAS v4u*)tab;
        int c = n; asm volatile("" : "+v"(c));
        int hq = hh; asm volatile("" : "+v"(hq));
#pragma unroll
        for (int t = 0; t < 4; ++t)
#pragma unroll
            for (int s2 = 0; s2 < 2; ++s2) { float e[8];
#pragma unroll
                for (int j = 0; j < 8; ++j) { const int rho = 16 * s2 + 8 * (j >> 2) + 4 * hq + (j & 3), pp = 32 * (t & 1) + rho;
                    float v = 0.f; if (c < 16) v = (t < 2) ? c_re[((size_t)dg * SG + c) * SP + pp] : -c_im[((size_t)dg * SG + c) * SP + pp]; e[j] = v; }
                v4u w; w.x = pk2(e[0], e[1]); w.y = pk2(e[2], e[3]); w.z = pk2(e[4], e[5]); w.w = pk2(e[6], e[7]); ctab[(t * 2 + s2) * 64 + lane] = w; }
    }
    LDS_WAIT();
    {
        const LAS bf16x8* ctab = (const LAS bf16x8*)tab;
        float* Y = dir ? Y1 : Y0;
        float* yp = Y + (((size_t)g * MTOK + (size_t)b * SEQ + (dir ? (SEQ - 1 - 64 * n) : 64 * n)) * SG) + 4 * hh;
        const long ystep = dir ? -(long)SG : (long)SG;
        const bf16* up = up0;
#define SSM_CPROJ(Ht, t) do { \
    v4u w0; w0.x = pk2(Ht[0], Ht[1]); w0.y = pk2(Ht[2], Ht[3]); w0.z = pk2(Ht[4], Ht[5]); w0.w = pk2(Ht[6], Ht[7]); \
    v4u w1; w1.x = pk2(Ht[8], Ht[9]); w1.y = pk2(Ht[10], Ht[11]); w1.z = pk2(Ht[12], Ht[13]); w1.w = pk2(Ht[14], Ht[15]); \
    Yc = __builtin_amdgcn_mfma_f32_32x32x16_bf16(ctab[((t) * 2 + 0) * 64 + lane], *reinterpret_cast<bf16x8*>(&w0), Yc, 0, 0, 0); \
    Yc = __builtin_amdgcn_mfma_f32_32x32x16_bf16(ctab[((t) * 2 + 1) * 64 + lane], *reinterpret_cast<bf16x8*>(&w1), Yc, 0, 0, 0); } while (0)
#define SSM_OUT(sidx) do { f32x16 Yc = zero16; SSM_CPROJ(H0, 0); SSM_CPROJ(H1, 1); SSM_CPROJ(H2, 2); SSM_CPROJ(H3, 3); \
    float* yq = yp + (sidx) * ystep; *(f32x4*)yq = (f32x4){Yc[0], Yc[1], Yc[2], Yc[3]}; *(f32x4*)(yq + 8) = (f32x4){Yc[4], Yc[5], Yc[6], Yc[7]}; } while (0)
        bf16x8 ua0 = *(const bf16x8*)up, ua1 = *(const bf16x8*)(up + ustep);
#pragma unroll 1
        for (int s = 0; s < 64; s += 2) {
            const bf16x8 n0 = *(const bf16x8*)(up + ((s + 2) & 63) * ustep), n1 = *(const bf16x8*)(up + ((s + 3) & 63) * ustep);
            SSM_STEP(ua0); SSM_OUT(s); SSM_STEP(ua1); SSM_OUT(s + 1);
            ua0 = n0; ua1 = n1;
        }
#undef SSM_OUT
#undef SSM_CPROJ
    }
#undef SSM_STEP
#undef SSM_HALF
#undef SSM_BF
    VM_WAIT(); __syncthreads();
    {
        const float* dsk = in[15]; const int tid = wid * 64 + lane;
#pragma unroll 4
        for (int i = tid; i < MTOK * 2; i += NWAVES * 64) {
            const int row = i >> 1, c8 = (i & 1) * 8; const size_t goff = ((size_t)g * MTOK + row) * SG + c8;
            const v4u uu = *(const v4u*)(U + goff); const f32x4 d0 = *(const f32x4*)(dsk + g * SG + c8), d1 = *(const f32x4*)(dsk + g * SG + c8 + 4);
            const f32x4 a0 = *(const f32x4*)(Y0 + goff), a1 = *(const f32x4*)(Y0 + goff + 4), b0 = *(const f32x4*)(Y1 + goff), b1 = *(const f32x4*)(Y1 + goff + 4);
            v4u z; z.x = pk2(gelu_tanh(d0[0] * bflo(uu.x) + a0[0] + b0[0]), gelu_tanh(d0[1] * bfhi(uu.x) + a0[1] + b0[1]));
            z.y = pk2(gelu_tanh(d0[2] * bflo(uu.y) + a0[2] + b0[2]), gelu_tanh(d0[3] * bfhi(uu.y) + a0[3] + b0[3]));
            z.z = pk2(gelu_tanh(d1[0] * bflo(uu.z) + a1[0] + b1[0]), gelu_tanh(d1[1] * bfhi(uu.z) + a1[1] + b1[1]));
            z.w = pk2(gelu_tanh(d1[2] * bflo(uu.w) + a1[2] + b1[2]), gelu_tanh(d1[3] * bfhi(uu.w) + a1[3] + b1[3]));
            *(v4u*)(Z + (size_t)row * SW + g * SG + c8) = z;
        }
    }
}


#ifndef TAP
#define TAP 0
#endif
#define TAP_FILL(EXPR) do { xcd_barrier(bar); { PHASE_IDS(); for (size_t i = (size_t)bx * 512 + tid; i < (size_t)MTOK * DM; i += (size_t)G * 512) { const size_t r = i >> 12; const int c = (int)(i & 4095); (void)r; (void)c; out[i] = (EXPR); } } return; } while (0)
__device__ __forceinline__ float bf2f(bf16 v) { return __uint_as_float(((unsigned)v) << 16); }
struct Args { const float* in[27]; float* out; unsigned char* ws; };
__global__ void __launch_bounds__(NWAVES * 64, 2) hybrid_fwd(Args args) {
    extern __shared__ __attribute__((aligned(16))) unsigned char lds_raw[];
    LAS unsigned char* lds = (LAS unsigned char*)lds_raw;
    volatile LAS unsigned* MISC = (volatile LAS unsigned*)(lds + MISC_OFF);
    const int wave = __builtin_amdgcn_readfirstlane((int)threadIdx.x >> 6);
#define PHASE_IDS() int lane = lane_id(); asm volatile("" : "+v"(lane)); const int tid = wave * 64 + lane; const int gw = vcu * NWAVES + wave; (void)tid; (void)gw
    const int G = gridDim.x, bx = blockIdx.x;
    const int vcu = (G % 8 == 0) ? (bx % 8) * (G / 8) + bx / 8 : bx;
    unsigned char* ws = args.ws;
    for (int u = threadIdx.x; u < (LDS_BYTES - MISC_OFF) / 4; u += NWAVES * 64) ((LAS unsigned*)(lds + MISC_OFF))[u] = 0u;
    __syncthreads();
    XcdBarrier bar = xcd_barrier_post((unsigned*)(ws + WS_CTL) + CW_BAR, MISC + 8, wave);
    const int NGW = G * NWAVES;

    bf16* WIN = (bf16*)(ws + WS_WIN); bf16* WA = (bf16*)(ws + WS_WA); bf16* WB = (bf16*)(ws + WS_WB); bf16* WOUT = (bf16*)(ws + WS_WOUT); bf16* WGLU = (bf16*)(ws + WS_WGLU);
    bf16* WUP = (bf16*)(ws + WS_WUP); bf16* WDOWN = (bf16*)(ws + WS_WDOWN); bf16* WPLE = (bf16*)(ws + WS_WPLE); bf16* WPG = (bf16*)(ws + WS_WPG);
    bf16* XN = (bf16*)(ws + WS_XN); bf16* PLEB = (bf16*)(ws + WS_PLEB); bf16* OUT1 = (bf16*)(ws + WS_OUT1); bf16* H1B = (bf16*)(ws + WS_H1B);
    bf16* Qb = (bf16*)(ws + WS_Q); bf16* Kb = (bf16*)(ws + WS_K); bf16* Vb = (bf16*)(ws + WS_V); bf16* Ub = (bf16*)(ws + WS_U); bf16* GAb = (bf16*)(ws + WS_GA); bf16* GBb = (bf16*)(ws + WS_GB);
    bf16* PART = (bf16*)(ws + WS_PART); float* ML = (float*)(ws + WS_ML); float* Y0 = (float*)(ws + WS_Y0); float* Y1 = (float*)(ws + WS_Y1);
    bf16* YA = (bf16*)(ws + WS_YA); bf16* Zb = (bf16*)(ws + WS_Z); bf16* YB = (bf16*)(ws + WS_YB); bf16* TMP = (bf16*)(ws + WS_TMP);
    float* EA = (float*)(ws + WS_EA); float* EB = (float*)(ws + WS_EB); bf16* ACT = (bf16*)(ws + WS_ACT);
    bf16* PB = (bf16*)(ws + WS_PB); float* ROPE = (float*)(ws + WS_ROPE); float* RPLE = (float*)(ws + WS_RPLE); float* SSMC = (float*)(ws + WS_SSMC);
    float* out = args.out; const float* x = args.in[0];

    {
        PHASE_IDS();
        LAS float* scr = (LAS float*)(lds + RING_OFF + wave * 16384);
        constexpr int I_IN = 64 * 512, I_PLE = 4 * 128;
        for (int it = gw; it < I_IN + I_PLE; it += NGW) {
            if (it < I_IN) transpose_item<1>(args.in[4], DM, INW, WIN, scr, it, lane);
            else transpose_item<0>(args.in[24], PLED, DM, WPLE, scr, it - I_IN, lane);
        }
        for (int m = gw; m < MTOK; m += NGW) rms_row_to_bf16(x + (size_t)m * DM, args.in[2], XN + (size_t)m * DM, lane);
        { const float* p = args.in[1];
          for (int i = bx * 512 + tid; i < MTOK * PLED / 8; i += G * 512) { const f32x4 a = *(const f32x4*)(p + (size_t)i * 8), c = *(const f32x4*)(p + (size_t)i * 8 + 4);
              v4u w; w.x = pk2(a[0], a[1]); w.y = pk2(a[2], a[3]); w.z = pk2(c[0], c[1]); w.w = pk2(c[2], c[3]); *(v4u*)(PB + (size_t)i * 8) = w; } }
        for (int i = bx * 512 + tid; i < 2 * NG * SP; i += G * 512) {
            const double lr = (double)args.in[8][i], li = (double)args.in[9][i], dt = (double)expf(args.in[10][i >> 6]);
            const double mag = exp_small(lr * dt); double s, c; sincos_rad(li * dt, s, c);
            const double ar = mag * c, ai = mag * s, den = lr * lr + li * li;
            const double fr = ((ar - 1.0) * lr + ai * li) / den, fi = (ai * lr - (ar - 1.0) * li) / den;
            const double magT = (double)expf((float)(lr * dt * 64.0)); double sT, cT; sincos_rad(li * dt * 64.0, sT, cT);
            *(f32x4*)(SSMC + (size_t)i * 8) = (f32x4){(float)ar, (float)ai, (float)(magT * cT), (float)(magT * sT)}; *(f32x4*)(SSMC + (size_t)i * 8 + 4) = (f32x4){(float)fr, (float)fi, 0.f, 0.f}; }
        for (int i = bx * 512 + tid; i < SEQ * 64; i += G * 512) { const int pos = i >> 6, f = i & 63;
            const float inv = exp2f(-(float)(2 * f) * (1.f / 128.f) * 13.287712379549449f);
            const float ang = (float)pos * inv; double s, c; sincos_rad((double)ang, s, c);
            ROPE[(size_t)pos * 128 + f] = (float)c; ROPE[(size_t)pos * 128 + 64 + f] = (float)s; }
    }
    xcd_barrier(bar);

    {
        pg8::Gemm g{XN, WIN, MTOK, INW, DM}; pg8::StaticOrder S; S.init(MTOK, INW, G, bx);
        EpiIn E{Qb, Kb, Vb, Ub, GAb, GBb, ROPE};
        pg8::gemm_phase<EpiIn, pg8::StaticOrder, true, true>(lds + RING_OFF, g, S, E, wave);
    }
    {
        pg8::Gemm g{PB, WPLE, MTOK, DM, PLED}; pg8::StaticOrder S; S.init(MTOK, DM, G, bx);
        EpiPlain E{PLEB, DM, 0, 0};
        pg8::gemm_phase<EpiPlain, pg8::StaticOrder, true, true>(lds + RING_OFF, g, S, E, wave);
    }
#if TAP == 11
    TAP_FILL(bf2f(GAb[i]) + bf2f(GBb[i]));
#endif
#if TAP == 12
    TAP_FILL(bf2f(PLEB[i]));
#endif
#if TAP == 1
    TAP_FILL(bf2f(Qb[r * 2048 + (c & 2047)]) + bf2f(Kb[r * 2048 + (c & 2047)]) + bf2f(Vb[r * 2048 + (c & 2047)]) + bf2f(Ub[r * 2048 + (c & 2047)]) + bf2f(GAb[i]) + bf2f(GBb[i]) + bf2f(PLEB[i]));
#endif
    xcd_barrier(bar);

    {
        constexpr int I_A = 32 * 128, I_OUT = 64 * 128, I_GLU = 32 * 64, I_UP = 64 * 768, I_DOWN = 192 * 128;
        constexpr int NCONVW = I_UP + I_DOWN + 2 * I_A + 2 * I_OUT + I_GLU, NCONV = NCONVW / 64, NATT = 1536, NITEM = NG + NCONV + NATT;
        static_assert(NCONVW % 64 == 0 && NCONV >= NATT, "conversion items");
        unsigned* qctr = (unsigned*)(ws + WS_CTL) + CW_QUEUE;
        volatile LAS unsigned* qslot = MISC + 16;
        const bool t0 = (wave == 0 && lane_id() == 0);
        unsigned nxt = 0u; if (t0) nxt = __hip_atomic_fetch_add(qctr, 1u, __ATOMIC_RELAXED, __HIP_MEMORY_SCOPE_AGENT);
        for (;;) {
            __syncthreads();
            if (t0) *qslot = nxt;
            __syncthreads();
            const int w = __builtin_amdgcn_readfirstlane((int)*qslot);
            if (w >= NITEM) break;
            if (t0) nxt = __hip_atomic_fetch_add(qctr, 1u, __ATOMIC_RELAXED, __HIP_MEMORY_SCOPE_AGENT);
            if (w < NG) { ssm_group(w, args.in, SSMC, Ub, Y0, Y1, Zb, (LAS char*)lds, wave); continue; }
            const int k = w - NG; int cv = -1, au = -1;
            if (k < 2 * NATT) { if (k & 1) au = k >> 1; else cv = k >> 1; } else cv = k - NATT;
            if (au >= 0) { att::attn_unit(au, Qb, Kb, Vb, PART, ML, (LAS char*)lds, wave); continue; }
            {
                int lane = lane_id(); asm volatile("" : "+v"(lane));
                LAS float* scr = (LAS float*)(lds + RING_OFF + wave * 16384);
                auto ref = [&](int j) { TRef t; int r = cv * 64 + j * 8 + wave;
                    t.up = 0; if (r < I_UP) { t.W = args.in[20]; t.WT = WUP; t.K = DM; t.N = 2 * DFF; t.item = r; t.up = 1; return t; } r -= I_UP;
                    if (r < I_DOWN) { t.W = args.in[23]; t.WT = WDOWN; t.K = DFF; t.N = DM; t.item = r; return t; } r -= I_DOWN;
                    if (r < I_A) { t.W = args.in[5]; t.WT = WA; t.K = AW; t.N = DM; t.item = r; return t; } r -= I_A;
                    if (r < I_A) { t.W = args.in[6]; t.WT = WB; t.K = SW; t.N = DM; t.item = r; return t; } r -= I_A;
                    if (r < I_OUT) { t.W = args.in[7]; t.WT = WOUT; t.K = DM; t.N = DM; t.item = r; return t; } r -= I_OUT;
                    if (r < I_GLU) { t.W = args.in[16]; t.WT = WGLU; t.K = SW; t.N = SW; t.item = r; return t; } r -= I_GLU;
                    t.W = args.in[26]; t.WT = WPG; t.K = DM; t.N = DM; t.item = r; return t; };
                float va[32], vb[32];
                TRef ta = ref(0), tb; titem_load(ta, va, lane);
#pragma unroll 1
                for (int j = 0; j < 8; j += 2) {
                    tb = ref(j + 1); titem_load(tb, vb, lane);
                    if (ta.up) titem_store<2>(ta, va, scr, lane); else titem_store<0>(ta, va, scr, lane);
                    if (j + 2 < 8) { ta = ref(j + 2); titem_load(ta, va, lane); }
                    if (tb.up) titem_store<2>(tb, vb, scr, lane); else titem_store<0>(tb, vb, scr, lane);
                }
            }
        }
    }
    xcd_barrier(bar);

    {
        PHASE_IDS();
        for (int i = bx * 512 + tid; i < MTOK * AW / 8; i += G * 512) {
            const int tok = i >> 8, c8 = (i & 255) * 8, h = c8 >> 7;
            float m[3], l[3];
#pragma unroll
            for (int p = 0; p < 3; ++p) { const float* mp = ML + (((size_t)p * MTOK + tok) * AH + h) * 2; m[p] = mp[0]; l[p] = mp[1]; }
            const float mm = fmaxf(m[0], fmaxf(m[1], m[2]));
            float w[3]; float ws_ = 0.f;
#pragma unroll
            for (int p = 0; p < 3; ++p) { w[p] = __builtin_amdgcn_exp2f((m[p] - mm) * att::CEXP) * l[p]; ws_ += w[p]; }
            const float rw = 1.f / ws_;
            float acc[8] = {0.f, 0.f, 0.f, 0.f, 0.f, 0.f, 0.f, 0.f};
#pragma unroll
            for (int p = 0; p < 3; ++p) { const v4u q = *(const v4u*)(PART + ((size_t)p * MTOK + tok) * AW + c8); const float wp = w[p] * rw;
                acc[0] += wp * bflo(q.x); acc[1] += wp * bfhi(q.x); acc[2] += wp * bflo(q.y); acc[3] += wp * bfhi(q.y); acc[4] += wp * bflo(q.z); acc[5] += wp * bfhi(q.z); acc[6] += wp * bflo(q.w); acc[7] += wp * bfhi(q.w); }
            v4u o; o.x = pk2(acc[0], acc[1]); o.y = pk2(acc[2], acc[3]); o.z = pk2(acc[4], acc[5]); o.w = pk2(acc[6], acc[7]);
            *(v4u*)(YA + (size_t)tok * AW + c8) = o;
        }
    }
#if TAP == 2
    TAP_FILL(bf2f(YA[r * 2048 + (c & 2047)]) + bf2f(Zb[r * 2048 + (c & 2047)]));
#endif
#if TAP == 21
    TAP_FILL(bf2f(YA[r * 2048 + (c & 2047)]));
#endif
#if TAP == 22
    TAP_FILL(bf2f(Zb[r * 2048 + (c & 2047)]));
#endif
    xcd_barrier(bar);

    {
        pg8::Gemm g{Zb, WGLU, MTOK, SW, SW}; pg8::StaticOrder S; S.init(MTOK, SW, G, bx);
        EpiGlu E{Zb, YB, args.in[17]};
        pg8::gemm_phase<EpiGlu, pg8::StaticOrder, true, true>(lds + RING_OFF, g, S, E, wave);
    }
#if TAP == 30
    TAP_FILL(bf2f(YB[r * 2048 + (c & 2047)]));
#endif
    xcd_barrier(bar);

    {
        pg8::Gemm g{YA, WA, MTOK, DM, AW}; pg8::StaticOrder S; S.init(MTOK, DM, G, bx);
        EpiGate<true> E{GAb, TMP};
        pg8::gemm_phase<EpiGate<true>, pg8::StaticOrder, true, true>(lds + RING_OFF, g, S, E, wave);
    }
#if TAP == 31
    TAP_FILL(bf2f(TMP[i]));
#endif
    VM_WAIT(); __syncthreads();
    {
        pg8::Gemm g{YB, WB, MTOK, DM, SW}; pg8::StaticOrder S; S.init(MTOK, DM, G, bx);
        EpiGate<false> E{GBb, TMP};
        pg8::gemm_phase<EpiGate<false>, pg8::StaticOrder, true, true>(lds + RING_OFF, g, S, E, wave);
    }
#if TAP == 3
    TAP_FILL(bf2f(TMP[i]) + bf2f(YB[r * 2048 + (c & 2047)]));
#endif
    xcd_barrier(bar);

    {
        pg8::Gemm g{TMP, WOUT, MTOK, DM, DM}; pg8::StaticOrder S; S.init(MTOK, DM, G, bx);
        EpiPlain E{OUT1, DM, 0, 0};
        pg8::gemm_phase<EpiPlain, pg8::StaticOrder, true, true>(lds + RING_OFF, g, S, E, wave);
    }
    xcd_barrier(bar);

    { PHASE_IDS();
    const int o16 = lane * 16, o8 = lane * 8;
    const rsrc_t rg1 = mk_rsrc(args.in[3], DM * 4), rg2 = mk_rsrc(args.in[18], DM * 4);
    for (int m = gw; m < MTOK; m += NGW) {
        const rsrc_t ro = mk_rsrc(OUT1 + (size_t)m * DM, DM * 2), rx = mk_rsrc(x + (size_t)m * DM, DM * 4), rh = mk_rsrc(H1B + (size_t)m * DM, DM * 2), rn = mk_rsrc(XN + (size_t)m * DM, DM * 2);
        f32x4 v[16]; float ss = 0.f;
#pragma unroll
        for (int j = 0; j < 16; ++j) { const v2u w = bl8(ro, o8, 512 * j); v[j] = (f32x4){bflo(w.x), bfhi(w.x), bflo(w.y), bfhi(w.y)}; ss += (v[j].x * v[j].x + v[j].y * v[j].y) + (v[j].z * v[j].z + v[j].w * v[j].w); }
        const float rstd = 1.f / sqrtf(wave_sum(ss) * (1.f / DM) + EPS); float s2 = 0.f;
#pragma unroll
        for (int j = 0; j < 16; ++j) { const f32x4 g = bl16(rg1, o16, 1024 * j); v[j] = bl16(rx, o16, 1024 * j) + v[j] * rstd * g; s2 += (v[j].x * v[j].x + v[j].y * v[j].y) + (v[j].z * v[j].z + v[j].w * v[j].w); }
        const float rstd2 = 1.f / sqrtf(wave_sum(s2) * (1.f / DM) + EPS);
#pragma unroll
        for (int j = 0; j < 16; ++j) { v2u hw; hw.x = pk2(v[j].x, v[j].y); hw.y = pk2(v[j].z, v[j].w); bs8(hw, rh, o8, 512 * j); const f32x4 g = bl16(rg2, o16, 1024 * j); v2u w; w.x = pk2(v[j].x * rstd2 * g.x, v[j].y * rstd2 * g.y); w.y = pk2(v[j].z * rstd2 * g.z, v[j].w * rstd2 * g.w); bs8(w, rn, o8, 512 * j); }
    } }
#if TAP == 4
    TAP_FILL(bf2f(H1B[i]) + bf2f(XN[i]));
#endif
    xcd_barrier(bar);

    {
        pg8::Gemm g{XN, WUP, MTOK, 2 * DFF, DM}; pg8::StaticOrder S; S.init(MTOK, 2 * DFF, G, bx);
        EpiUp E{ACT, EA, EB, args.in[21], args.in[22]};
        pg8::gemm_phase<EpiUp, pg8::StaticOrder, true, true>(lds + RING_OFF, g, S, E, wave);
    }
    xcd_barrier(bar);

    {
        PHASE_IDS();
        const float* cw = args.in[21]; const float* cb = args.in[22];
        constexpr int NC4 = DFF / 4;
        for (int i = bx * 512 + tid; i < 128 * 2 * NC4; i += G * 512) {
            const int c4 = (i % NC4) * 4, rs = (i / NC4) & 1, blk = i / (2 * NC4), R = blk * 64 + (rs ? 63 : 0), t = R & (SEQ - 1);
            const f32x4 zero4 = (f32x4){0.f, 0.f, 0.f, 0.f};
            f32x4 prev, cur, next, bv;
            if (!rs) { cur = *(const f32x4*)(EA + ((size_t)blk * 4 + 0) * DFF + c4); next = *(const f32x4*)(EA + ((size_t)blk * 4 + 1) * DFF + c4);
                       prev = t == 0 ? zero4 : *(const f32x4*)(EA + ((size_t)(blk - 1) * 4 + 3) * DFF + c4); bv = *(const f32x4*)(EB + ((size_t)blk * 2) * DFF + c4); }
            else     { cur = *(const f32x4*)(EA + ((size_t)blk * 4 + 3) * DFF + c4); prev = *(const f32x4*)(EA + ((size_t)blk * 4 + 2) * DFF + c4);
                       next = t == SEQ - 1 ? zero4 : *(const f32x4*)(EA + ((size_t)(blk + 1) * 4 + 0) * DFF + c4); bv = *(const f32x4*)(EB + ((size_t)blk * 2 + 1) * DFF + c4); }
            const f32x4 w0 = *(const f32x4*)(cw + c4), w1 = *(const f32x4*)(cw + DFF + c4), w2 = *(const f32x4*)(cw + 2 * DFF + c4), bs = *(const f32x4*)(cb + c4);
            float o[4];
#pragma unroll
            for (int e = 0; e < 4; ++e) o[e] = gelu_tanh(bs[e] + w0[e] * prev[e] + w1[e] * cur[e] + w2[e] * next[e]) * bv[e];
            v2u w; w.x = pk2(o[0], o[1]); w.y = pk2(o[2], o[3]);
            *(v2u*)(ACT + (size_t)R * DFF + c4) = w;
        }
    }
#if TAP == 5
    TAP_FILL(bf2f(ACT[r * DFF + c]) + bf2f(ACT[r * DFF + 4096 + c]) + bf2f(ACT[r * DFF + 8192 + c]));
#endif
    xcd_barrier(bar);

    {
        pg8::Gemm g{ACT, WDOWN, MTOK, DM, DFF}; pg8::StaticOrder S; S.init(MTOK, DM, G, bx);
        EpiPlain E{OUT1, DM, 0, 0};
        pg8::gemm_phase<EpiPlain, pg8::StaticOrder, true, true>(lds + RING_OFF, g, S, E, wave);
    }
    xcd_barrier(bar);

    { PHASE_IDS();
    const int o16 = lane * 16, o8 = lane * 8;
    const rsrc_t rg1 = mk_rsrc(args.in[19], DM * 4);
    for (int m = gw; m < MTOK; m += NGW) {
        const rsrc_t ro = mk_rsrc(OUT1 + (size_t)m * DM, DM * 2), rh = mk_rsrc(H1B + (size_t)m * DM, DM * 2), rn = mk_rsrc(XN + (size_t)m * DM, DM * 2), rp_ = mk_rsrc(PLEB + (size_t)m * DM, DM * 2);
        f32x4 v[16]; float ss = 0.f;
#pragma unroll
        for (int j = 0; j < 16; ++j) { const v2u w = bl8(ro, o8, 512 * j); v[j] = (f32x4){bflo(w.x), bfhi(w.x), bflo(w.y), bfhi(w.y)}; ss += (v[j].x * v[j].x + v[j].y * v[j].y) + (v[j].z * v[j].z + v[j].w * v[j].w); }
        const float rstd = 1.f / sqrtf(wave_sum(ss) * (1.f / DM) + EPS);
#pragma unroll
        for (int j = 0; j < 16; ++j) { const f32x4 g = bl16(rg1, o16, 1024 * j); const v2u h1 = bl8(rh, o8, 512 * j); const f32x4 hv = (f32x4){bflo(h1.x), bfhi(h1.x), bflo(h1.y), bfhi(h1.y)} + v[j] * rstd * g; v2u w; w.x = pk2(hv.x, hv.y); w.y = pk2(hv.z, hv.w); bs8(w, rn, o8, 512 * j); }
        float sp = 0.f;
#pragma unroll
        for (int j = 0; j < 16; ++j) { const v2u w = bl8(rp_, o8, 512 * j); const float a = bflo(w.x), b = bfhi(w.x), c = bflo(w.y), d = bfhi(w.y); sp += (a * a + b * b) + (c * c + d * d); }
        const float rp = 1.f / sqrtf(wave_sum(sp) * (1.f / DM) + EPS);
        if (lane == 0) RPLE[m] = rp;
    } }
#if TAP == 6
    TAP_FILL(bf2f(XN[i]) + RPLE[r]);
#endif
    xcd_barrier(bar);

    {
        pg8::Gemm g{XN, WPG, MTOK, DM, DM}; pg8::StaticOrder S; S.init(MTOK, DM, G, bx);
        EpiFinal E{out, XN, PLEB, RPLE, args.in[25]};
        pg8::gemm_phase<EpiFinal, pg8::StaticOrder, true, true>(lds + RING_OFF, g, S, E, wave);
    }
}

extern "C" void kernel_launch(void* const* d_in, const int* in_sizes, int n_in, void* d_out, int out_size, void* d_ws, size_t ws_size, hipStream_t stream) {
    static int grid = 0;
    if (grid == 0) {
        if (n_in != 27 || out_size != MTOK * DM || ws_size < WS_END) { fprintf(stderr, "kernel_launch: unexpected shapes: n_in %d out %d ws %zu (need >= %zu)\n", n_in, out_size, ws_size, (size_t)WS_END); grid = -1; return; }
        int dev = 0, cus = 0, per_cu = 0;
        if (hipGetDevice(&dev) != hipSuccess || hipDeviceGetAttribute(&cus, hipDeviceAttributeMultiprocessorCount, dev) != hipSuccess) { grid = -1; return; }
        if (hipFuncSetAttribute((const void*)hybrid_fwd, hipFuncAttributeMaxDynamicSharedMemorySize, LDS_BYTES) != hipSuccess) { fprintf(stderr, "kernel_launch: hipFuncSetAttribute failed\n"); grid = -1; return; }
        if (hipOccupancyMaxActiveBlocksPerMultiprocessor(&per_cu, (const void*)hybrid_fwd, NWAVES * 64, LDS_BYTES) != hipSuccess || per_cu < 1)
            fprintf(stderr, "kernel_launch: note: occupancy query reports %d workgroups per CU\n", per_cu);
        (void)hipGetLastError();
        grid = cus;
    }
    if (grid < 0) return;
    if (hipMemsetAsync((char*)d_ws + WS_CTL, 0, CTL_ZERO_BYTES, stream) != hipSuccess) { fprintf(stderr, "kernel_launch: memset failed\n"); return; }
    Args a{};
    for (int i = 0; i < 27; ++i) a.in[i] = (const float*)d_in[i];
    a.out = (float*)d_out; a.ws = (unsigned char*)d_ws;
    hipLaunchKernelGGL(hybrid_fwd, dim3(grid), dim3(NWAVES * 64), LDS_BYTES, stream, a);
    const hipError_t le = hipPeekAtLastError();
    if (le != hipSuccess) fprintf(stderr, "kernel_launch: launch failed: %s\n", hipGetErrorName(le));
}
```
